# Optimizing an MI355X kernel written in HIP

```python
import jax
import jax.numpy as jnp
from jax import lax
import numpy as np

D_MODEL = 2048
BATCH = 4
SEQ = 2048
DEPTH = 1
DEC_BATCH = 128
DEC_SEQ = 8
PAST_LEN = 8192
PAGE_SIZE = 128

RW_HEADS = 12
RW_HEAD_DIM = 64
RW_WIDTH = RW_HEADS * RW_HEAD_DIM
RW_DECAY_RANK = 64
RW_A_RANK = 64
RW_GATE_RANK = 128
RW_PROJ = 3 * RW_WIDTH + RW_DECAY_RANK + RW_A_RANK + RW_GATE_RANK
RW_GN_EPS = 6.4e-4
SWA_Q_HEADS = 12
SWA_KV_HEADS = 4
SWA_GROUP = SWA_Q_HEADS // SWA_KV_HEADS
SWA_HEAD_DIM = 64
SWA_Q_WIDTH = SWA_Q_HEADS * SWA_HEAD_DIM
SWA_KV_WIDTH = SWA_KV_HEADS * SWA_HEAD_DIM
WINDOW = 128
MEM_TOKENS = 256
MEM_HEADS = 4
MEM_HEAD_DIM = 128
MEM_WIDTH = MEM_HEADS * MEM_HEAD_DIM
N_BRANCH = 3
P_IN = RW_PROJ + SWA_Q_WIDTH + 2 * SWA_KV_WIDTH + MEM_WIDTH + N_BRANCH * D_MODEL
D_FF = 5632
CONV_W = 3
NORM_EPS = 1e-6

kernel_name = 'hybrid_rwkv7_swa_sink_mem_convglu_step'


def _rmsnorm(x, g):
    xf = x.astype(jnp.float32)
    y = xf * lax.rsqrt(jnp.mean(xf * xf, axis=-1, keepdims=True) + NORM_EPS)
    return (y * g.astype(jnp.float32)).astype(x.dtype)


def _wkv7_step(S, inp):
    r, w, k, v, kk, a = inp
    sa = jnp.einsum('bhvk,bhk->bhv', S, -kk)
    S = S * w[:, :, None, :] + sa[..., None] * (kk * a)[:, :, None, :] + v[..., None] * k[:, :, None, :]
    return S, jnp.einsum('bhvk,bhk->bhv', S, r)


def _rwkv7(p, prev_row, s0, prm):
    b, t, _ = p.shape
    f32 = jnp.float32
    prev = jnp.concatenate([prev_row[:, None, :].astype(p.dtype), p[:, :-1]], axis=1)
    s = p + prm['mu_rwkv'] * (prev - p)
    o1 = RW_WIDTH
    o2 = 2 * RW_WIDTH
    o3 = 3 * RW_WIDTH
    o4 = o3 + RW_DECAY_RANK
    o5 = o4 + RW_A_RANK
    r, k, v, wl, al, gl = jnp.split(s, [o1, o2, o3, o4, o5], axis=-1)
    w_log = -jax.nn.softplus(-(prm['w0_decay'] + jnp.tanh(wl) @ prm['w_decay_up']).astype(f32)) - 0.5
    decay = jnp.exp(-jnp.exp(w_log))
    a = jax.nn.sigmoid((prm['a0'] + al @ prm['w_a_up']).astype(f32))
    g = jax.nn.sigmoid(gl) @ prm['w_gate_up']
    hn = (RW_HEADS, RW_HEAD_DIM)
    heads = lambda z: z.astype(f32).reshape(b, t, RW_HEADS, RW_HEAD_DIM)
    r, k, v, decay, a = heads(r), heads(k), heads(v), heads(decay), heads(a)
    kk = k * prm['k_k'].astype(f32).reshape(hn)
    kk = kk / jnp.maximum(jnp.sqrt(jnp.sum(kk * kk, axis=-1, keepdims=True)), 1e-12)
    k = k * (1.0 + (a - 1.0) * prm['k_a'].astype(f32).reshape(hn))
    xs = tuple(jnp.swapaxes(z, 0, 1) for z in (r, decay, k, v, kk, a))
    s_fin, o = lax.scan(_wkv7_step, s0.astype(f32), xs)
    o = jnp.swapaxes(o, 0, 1)
    mean = jnp.mean(o, axis=-1, keepdims=True)
    var = jnp.mean(jnp.square(o - mean), axis=-1, keepdims=True)
    o = (o - mean) * lax.rsqrt(var + RW_GN_EPS)
    o = o.reshape(b, t, RW_WIDTH) * prm['ln_x_w'].astype(f32) + prm['ln_x_b'].astype(f32)
    bonus = jnp.sum(r * k * prm['r_k'].astype(f32), axis=-1, keepdims=True) * v
    o = (o + bonus.reshape(b, t, RW_WIDTH)) * g.astype(f32)
    return o.astype(p.dtype), p[:, -1], s_fin


def _sink_softmax(s, mask, sinks):
    s = jnp.where(mask, s, -jnp.inf)
    sk = sinks.astype(jnp.float32)[:, :, None, None]
    m = jnp.maximum(jnp.max(s, axis=-1, keepdims=True), sk)
    e = jnp.exp(s - m)
    return e / (jnp.sum(e, axis=-1, keepdims=True) + jnp.exp(sk - m))


def _swa_prompt(q, k, v, sinks):
    b, t = q.shape[:2]
    nb = t // WINDOW
    qb = q.reshape(b, nb, WINDOW, SWA_KV_HEADS, SWA_GROUP, SWA_HEAD_DIM)
    pad = jnp.zeros((b, WINDOW, SWA_KV_HEADS, SWA_HEAD_DIM), k.dtype)
    kb = jnp.concatenate([pad, k], axis=1).reshape(b, nb + 1, WINDOW, SWA_KV_HEADS, SWA_HEAD_DIM)
    vb = jnp.concatenate([pad, v], axis=1).reshape(b, nb + 1, WINDOW, SWA_KV_HEADS, SWA_HEAD_DIM)
    kw = jnp.concatenate([kb[:, :-1], kb[:, 1:]], axis=2)
    vw = jnp.concatenate([vb[:, :-1], vb[:, 1:]], axis=2)
    s = jnp.einsum('bnqhgd,bnkhd->bnhgqk', qb, kw, preferred_element_type=jnp.float32) * (SWA_HEAD_DIM ** -0.5)
    i = jnp.arange(WINDOW)[:, None]
    j = jnp.arange(2 * WINDOW)[None, :]
    blk = jnp.arange(nb)[:, None, None]
    mask = (j > i) & (j <= i + WINDOW) & (blk * WINDOW + j >= WINDOW)
    pr = _sink_softmax(s, mask[None, :, None, None], sinks.reshape(SWA_KV_HEADS, SWA_GROUP))
    o = jnp.einsum('bnhgqk,bnkhd->bnqhgd', pr.astype(v.dtype), vw)
    keep = min(WINDOW, t)
    return o.reshape(b, t, SWA_Q_WIDTH), k[:, t - keep:], v[:, t - keep:]


def _swa_step(q, k, v, ck, cv, sinks):
    b, t = q.shape[:2]
    wb = ck.shape[1]
    kf = jnp.concatenate([ck.astype(k.dtype), k], axis=1)
    vf = jnp.concatenate([cv.astype(v.dtype), v], axis=1)
    qg = q.reshape(b, t, SWA_KV_HEADS, SWA_GROUP, SWA_HEAD_DIM)
    s = jnp.einsum('bqhgd,bkhd->bhgqk', qg, kf, preferred_element_type=jnp.float32) * (SWA_HEAD_DIM ** -0.5)
    rel = jnp.arange(t)[:, None] + wb - jnp.arange(wb + t)[None, :]
    mask = (rel >= 0) & (rel < WINDOW)
    pr = _sink_softmax(s, mask, sinks.reshape(SWA_KV_HEADS, SWA_GROUP))
    o = jnp.einsum('bhgqk,bkhd->bqhgd', pr.astype(vf.dtype), vf)
    return o.reshape(b, t, SWA_Q_WIDTH), kf[:, -wb:], vf[:, -wb:]


def _mem_kv(mem, g_mem, w_mem_kv):
    b, m, _ = mem.shape
    kv = _rmsnorm(mem, g_mem) @ w_mem_kv
    mk, mv = jnp.split(kv, 2, axis=-1)
    return mk.reshape(b, m, MEM_HEADS, MEM_HEAD_DIM), mv.reshape(b, m, MEM_HEADS, MEM_HEAD_DIM)


def _mem_attend(q, mk, mv):
    b, t = q.shape[:2]
    qh = q.reshape(b, t, MEM_HEADS, MEM_HEAD_DIM)
    s = jnp.einsum('bthd,bmhd->bhtm', qh, mk.astype(q.dtype), preferred_element_type=jnp.float32) * (MEM_HEAD_DIM ** -0.5)
    pr = jax.nn.softmax(s, axis=-1)
    o = jnp.einsum('bhtm,bmhd->bthd', pr.astype(q.dtype), mv.astype(q.dtype))
    return o.reshape(b, t, MEM_WIDTH)


def _layer(x, swa_fn, mem_k, mem_v, shift_prev, wkv_prev, conv_prev, prm):
    b, t, _ = x.shape
    xn = _rmsnorm(x, prm['g_pre_mix'])
    p = xn @ prm['w_in']
    o1 = RW_PROJ
    o2 = o1 + SWA_Q_WIDTH
    o3 = o2 + SWA_KV_WIDTH
    o4 = o3 + SWA_KV_WIDTH
    o5 = o4 + MEM_WIDTH
    p_rw, q_sw, k_sw, v_sw, q_mem, p_gate = jnp.split(p, [o1, o2, o3, o4, o5], axis=-1)
    o_rw, shift_new, wkv_new = _rwkv7(p_rw, shift_prev, wkv_prev, prm)
    k_sw = k_sw.reshape(b, t, SWA_KV_HEADS, SWA_HEAD_DIM)
    v_sw = v_sw.reshape(b, t, SWA_KV_HEADS, SWA_HEAD_DIM)
    o_sw, kbuf, vbuf = swa_fn(q_sw, k_sw, v_sw)
    o_mem = _mem_attend(q_mem, mem_k, mem_v)
    gates = jax.nn.sigmoid(p_gate.astype(jnp.float32)).astype(x.dtype).reshape(b, t, N_BRANCH, D_MODEL)
    merged = (gates[:, :, 0] * (o_rw @ prm['w_br_rwkv'])
              + gates[:, :, 1] * (o_sw @ prm['w_br_swa'])
              + gates[:, :, 2] * (o_mem @ prm['w_br_mem']))
    h = x + _rmsnorm(merged @ prm['w_o'], prm['g_post_mix'])
    hn = _rmsnorm(h, prm['g_pre_ffn'])
    z_gate, z_val = jnp.split(hn @ prm['w_ffn_up'], 2, axis=-1)
    full = jnp.concatenate([conv_prev.astype(z_gate.dtype), z_gate], axis=1)
    conv = prm['conv_b']
    for j in range(CONV_W):
        conv = conv + prm['conv_w'][j] * full[:, j:j + t]
    f = (jax.nn.gelu(conv) * z_val) @ prm['w_ffn_down']
    y = h + _rmsnorm(f, prm['g_post_ffn'])
    return y, kbuf, vbuf, shift_new, wkv_new, full[:, -(CONV_W - 1):]


def setup_inputs(seed: int = 0) -> dict:
    key = jax.random.key(seed)
    ks = iter(jax.random.split(key, 48))
    f32 = jnp.float32
    nrm = lambda shape, scale: jax.random.normal(next(ks), shape, f32) * scale
    swa_buf = min(WINDOW, PAST_LEN)
    return {
        'x_prompt': nrm((BATCH, SEQ, D_MODEL), 1.0),
        'x_sample': nrm((DEC_BATCH, DEC_SEQ, D_MODEL), 1.0),
        'cache_swa_k': nrm((DEC_BATCH, swa_buf, SWA_KV_HEADS, SWA_HEAD_DIM), 1.0),
        'cache_swa_v': nrm((DEC_BATCH, swa_buf, SWA_KV_HEADS, SWA_HEAD_DIM), 1.0),
        'cache_mem_k': nrm((DEC_BATCH, MEM_TOKENS, MEM_HEADS, MEM_HEAD_DIM), 1.0),
        'cache_mem_v': nrm((DEC_BATCH, MEM_TOKENS, MEM_HEADS, MEM_HEAD_DIM), 1.0),
        'state_rwkv_shift': nrm((DEC_BATCH, RW_PROJ), 1.0),
        'state_rwkv_wkv': nrm((DEC_BATCH, RW_HEADS, RW_HEAD_DIM, RW_HEAD_DIM), 0.3),
        'state_ffn_conv': nrm((DEC_BATCH, CONV_W - 1, D_FF), 1.0),
        'mem_prompt': nrm((BATCH, MEM_TOKENS, D_MODEL), 1.0),
        'g_pre_mix': 1.0 + nrm((D_MODEL,), 0.05),
        'w_in': nrm((D_MODEL, P_IN), D_MODEL ** -0.5),
        'mu_rwkv': jax.random.uniform(next(ks), (RW_PROJ,), f32, 0.1, 0.9),
        'w_decay_up': nrm((RW_DECAY_RANK, RW_WIDTH), 0.5 * RW_DECAY_RANK ** -0.5),
        'w0_decay': nrm((RW_WIDTH,), 0.5),
        'w_a_up': nrm((RW_A_RANK, RW_WIDTH), RW_A_RANK ** -0.5),
        'a0': nrm((RW_WIDTH,), 0.3),
        'w_gate_up': nrm((RW_GATE_RANK, RW_WIDTH), RW_GATE_RANK ** -0.5),
        'k_k': 0.85 + nrm((RW_WIDTH,), 0.05),
        'k_a': 1.0 + nrm((RW_WIDTH,), 0.05),
        'r_k': nrm((RW_HEADS, RW_HEAD_DIM), 0.1),
        'ln_x_w': 1.0 + nrm((RW_WIDTH,), 0.05),
        'ln_x_b': nrm((RW_WIDTH,), 0.02),
        'swa_sinks': nrm((SWA_Q_HEADS,), 0.5),
        'g_mem': 1.0 + nrm((D_MODEL,), 0.05),
        'w_mem_kv': nrm((D_MODEL, 2 * MEM_WIDTH), D_MODEL ** -0.5),
        'w_br_rwkv': nrm((RW_WIDTH, D_MODEL), RW_WIDTH ** -0.5),
        'w_br_swa': nrm((SWA_Q_WIDTH, D_MODEL), SWA_Q_WIDTH ** -0.5),
        'w_br_mem': nrm((MEM_WIDTH, D_MODEL), MEM_WIDTH ** -0.5),
        'w_o': nrm((D_MODEL, D_MODEL), D_MODEL ** -0.5),
        'g_post_mix': 1.0 + nrm((D_MODEL,), 0.05),
        'g_pre_ffn': 1.0 + nrm((D_MODEL,), 0.05),
        'w_ffn_up': nrm((D_MODEL, 2 * D_FF), D_MODEL ** -0.5),
        'conv_w': nrm((CONV_W, D_FF), CONV_W ** -0.5),
        'conv_b': nrm((D_FF,), 0.02),
        'w_ffn_down': nrm((D_FF, D_MODEL), D_FF ** -0.5),
        'g_post_ffn': 1.0 + nrm((D_MODEL,), 0.05),
    }


def reference(x_prompt, x_sample, cache_swa_k, cache_swa_v, cache_mem_k, cache_mem_v,
              state_rwkv_shift, state_rwkv_wkv, state_ffn_conv, mem_prompt,
              g_pre_mix, w_in, mu_rwkv, w_decay_up, w0_decay, w_a_up, a0, w_gate_up,
              k_k, k_a, r_k, ln_x_w, ln_x_b, swa_sinks, g_mem, w_mem_kv,
              w_br_rwkv, w_br_swa, w_br_mem, w_o, g_post_mix, g_pre_ffn,
              w_ffn_up, conv_w, conv_b, w_ffn_down, g_post_ffn):
    prm = dict(g_pre_mix=g_pre_mix, w_in=w_in, mu_rwkv=mu_rwkv, w_decay_up=w_decay_up,
               w0_decay=w0_decay, w_a_up=w_a_up, a0=a0, w_gate_up=w_gate_up, k_k=k_k, k_a=k_a,
               r_k=r_k, ln_x_w=ln_x_w, ln_x_b=ln_x_b, w_br_rwkv=w_br_rwkv, w_br_swa=w_br_swa,
               w_br_mem=w_br_mem, w_o=w_o, g_post_mix=g_post_mix, g_pre_ffn=g_pre_ffn,
               w_ffn_up=w_ffn_up, conv_w=conv_w, conv_b=conv_b, w_ffn_down=w_ffn_down,
               g_post_ffn=g_post_ffn)
    bp = x_prompt.shape[0]
    dt = x_prompt.dtype
    swa_prompt_fn = lambda q, k, v: _swa_prompt(q, k, v, swa_sinks)
    swa_sample_fn = lambda q, k, v: _swa_step(q, k, v, cache_swa_k, cache_swa_v, swa_sinks)
    y_p = x_prompt
    y_s = x_sample
    for _ in range(DEPTH):
        mem_k_p, mem_v_p = _mem_kv(mem_prompt, g_mem, w_mem_kv)
        y_p, swa_k_p, swa_v_p, shift_p, wkv_p, conv_p = _layer(
            y_p, swa_prompt_fn, mem_k_p, mem_v_p,
            jnp.zeros((bp, RW_PROJ), dt),
            jnp.zeros((bp, RW_HEADS, RW_HEAD_DIM, RW_HEAD_DIM), jnp.float32),
            jnp.zeros((bp, CONV_W - 1, D_FF), dt), prm)
        y_s, swa_k_s, swa_v_s, shift_s, wkv_s, conv_s = _layer(
            y_s, swa_sample_fn, cache_mem_k, cache_mem_v,
            state_rwkv_shift, state_rwkv_wkv, state_ffn_conv, prm)
    return (y_p, y_s, swa_k_p, swa_v_p, mem_k_p, mem_v_p, shift_p, wkv_p, conv_p,
            swa_k_s, swa_v_s, shift_s, wkv_s, conv_s)
```

```cpp
#include <hip/hip_runtime.h>
#include <hip/hip_cooperative_groups.h>
#include <cstdio>
namespace pg8 {
#define PG8_LAS __attribute__((address_space(3)))
typedef unsigned short bf16_t;
typedef short bf16x8 __attribute__((ext_vector_type(8)));
typedef float f32x4 __attribute__((ext_vector_type(4)));
typedef unsigned u32x4 __attribute__((ext_vector_type(4)));
constexpr int BM = 256, BK = 64, HALF = 128, HTB = HALF * BK * 2  , STAGE_BYTES = 8 * HTB, NXCD = 8, WGM = 8;

__host__ __device__ __forceinline__ int lds_byte(int r, int c) { const int st = (r >> 4) * 2 + (c >> 5), rr = r & 15, cc = c & 31, ob = rr * 64 + cc * 2; return st * 1024 + (ob ^ (((ob >> 9) & 1) << 5)); }
__host__ __device__ __forceinline__ void stage_rc(int b, int& R, int& C) { const int st = b / 1024, sb = b % 1024, swz = sb ^ (((sb >> 9) & 1) << 5); R = (st >> 1) * 16 + swz / 64; C = (st & 1) * 32 + (swz % 64) / 2; }
__host__ __device__ __forceinline__ int perm32(int rho) { const int n = rho >> 4, i = rho & 15; return 8 * (i >> 2) + 4 * n + (i & 3); }

struct Unit { int pm, pn; };
struct Gemm { const bf16_t* A; const bf16_t* Bt; int M, N, K; };

struct StaticOrder {
    int nM, nN, nwg, G, c;
    __host__ __device__ void init(int M, int N, int G_, int c_) { nM = M / BM; nN = N / BM; nwg = nM * nN; G = G_; c = c_; }
    __host__ __device__ bool next(int i, Unit& u) const {
        const long L = (long)i * G + c; if (L >= nwg) return false;
        int wgid = (int)L; { const int q = nwg / NXCD, r = nwg % NXCD, xcd = wgid % NXCD, off = wgid / NXCD; wgid = (xcd < r ? xcd * (q + 1) : r * (q + 1) + (xcd - r) * q) + off; }
        const int nig = WGM * nN, gid = wgid / nig, fm = gid * WGM, gsz = (nM - fm) < WGM ? (nM - fm) : WGM;
        u.pm = fm + ((wgid % nig) % gsz); u.pn = (wgid % nig) / gsz; return true;
    }
    __device__ __forceinline__ void a_ready(const Unit&) const {}
    __device__ __forceinline__ void done(const Unit&) const {}
};
__device__ __forceinline__ unsigned cvt_pk_bf16(float lo, float hi) { unsigned r; asm volatile("v_cvt_pk_bf16_f32 %0, %1, %2" : "=v"(r) : "v"(lo), "v"(hi)); return r; }
typedef float f32x2 __attribute__((ext_vector_type(2)));
template <class Epi, class Sched, bool STAMP = false>
__device__ __forceinline__ void gemm_phase(PG8_LAS unsigned char* lds, const Gemm g, const Sched& S, const Epi& E, unsigned long long* stamps) {
    const int tid = threadIdx.x, wid = __builtin_amdgcn_readfirstlane(tid >> 6), lane = tid & 63, wr = wid >> 2, wc = wid & 3, fr = lane & 15, fq = lane >> 4;
    const int K = g.K, nt = K / BK;
    int ts_lo = 0, ts_hi = 0, nts = 0; const unsigned long long rt_entry = STAMP ? (unsigned long long)wall_clock64() : 0ull;
#define PG8_STAMP() do { if (STAMP && wid == 0 && nts < 64) { const unsigned long long _c = (unsigned long long)clock64(); \
        ts_lo = (lane == nts) ? (int)(unsigned)_c : ts_lo; ts_hi = (lane == nts) ? (int)(unsigned)(_c >> 32) : ts_hi; ++nts; } } while (0)
    PG8_STAMP();
    unsigned voffA[2], voffB[2];
#pragma unroll
    for (int i = 0; i < 2; ++i) { int R, C; stage_rc(tid * 16 + i * 8192, R, C); const int Rb = Epi::PERM ? ((R & ~31) + perm32(R & 31)) : R;
        voffA[i] = (unsigned)(R * K + C) * 2u; voffB[i] = (unsigned)(Rb * K + C) * 2u; }
    const size_t kstep = (size_t)(BK * 2);
    const size_t hstep = (size_t)HALF * K * 2;
    const size_t tstep = 2 * hstep;
    const unsigned ldsw = (unsigned)wid * 1024u;
    const int aoff = lds_byte(wr * 64 + fr, fq * 8), boff = lds_byte(wc * 32 + fr, fq * 8);
#define PG8_SA(b, h) (((b) * 2 + (h)) * HTB)
#define PG8_SB(b, h) ((4 + (b) * 2 + (h)) * HTB)
#define PG8_STAGE(bufoff, gbase, voff) do { _Pragma("unroll") for (int _i = 0; _i < 2; ++_i) \
        __builtin_amdgcn_global_load_lds((const unsigned*)((const char*)(gbase) + (voff)[_i]), (PG8_LAS unsigned*)(lds + (bufoff) + ldsw + _i * 8192), 16, 0, 0); } while (0)
#define PG8_LDA(dst, b, h) do { _Pragma("unroll") for (int m = 0; m < 4; ++m) _Pragma("unroll") for (int k = 0; k < 2; ++k) dst[m][k] = *(const PG8_LAS bf16x8*)(lds + PG8_SA(b, h) + aoff + m * 2048 + k * 1024); } while (0)
#define PG8_LDB(dst, b, h) do { _Pragma("unroll") for (int n = 0; n < 2; ++n) _Pragma("unroll") for (int k = 0; k < 2; ++k) dst[n][k] = *(const PG8_LAS bf16x8*)(lds + PG8_SB(b, h) + boff + n * 2048 + k * 1024); } while (0)
#define PG8_MMA(ai, bj, At, Bt) do { __builtin_amdgcn_s_setprio(1); _Pragma("unroll") for (int m = 0; m < 4; ++m) _Pragma("unroll") for (int n = 0; n < 2; ++n) _Pragma("unroll") for (int k = 0; k < 2; ++k) \
        acc[ai][bj][m][n] = __builtin_amdgcn_mfma_f32_16x16x32_bf16(Bt[n][k], At[m][k], acc[ai][bj][m][n], 0, 0, 0); __builtin_amdgcn_s_setprio(0); } while (0)
#define PG8_WAIT_V(n) asm volatile("s_waitcnt vmcnt(" #n ")" ::: "memory")
#define PG8_WAIT_L(n) asm volatile("s_waitcnt lgkmcnt(" #n ")" ::: "memory")
#define PG8_BAR __builtin_amdgcn_s_barrier()
#define PG8_SCHED __builtin_amdgcn_sched_barrier(0)
    Unit cur, nxt; int ui = 0;
    if (!S.next(0, cur)) return;
    f32x4 acc[2][2][4][2];
#pragma unroll
    for (int a = 0; a < 2; ++a)
#pragma unroll
        for (int b = 0; b < 2; ++b)
#pragma unroll
            for (int m = 0; m < 4; ++m)
#pragma unroll
                for (int n = 0; n < 2; ++n) acc[a][b][m][n] = (f32x4){0.f, 0.f, 0.f, 0.f};
    bf16x8 At[4][2], B0[2][2], B1[2][2];
    const char* cA = (const char*)g.A + (size_t)cur.pm * tstep; const char* cB = (const char*)g.Bt + (size_t)cur.pn * tstep;
    S.a_ready(cur);
    PG8_STAGE(PG8_SB(0, 0), cB, voffB); PG8_STAGE(PG8_SA(0, 0), cA, voffA); PG8_STAGE(PG8_SB(0, 1), cB + hstep, voffB); PG8_STAGE(PG8_SA(0, 1), cA + hstep, voffA);
    if (wr == 1) PG8_BAR;
    PG8_WAIT_V(4); PG8_BAR;
    PG8_STAGE(PG8_SB(1, 0), cB + kstep, voffB); PG8_STAGE(PG8_SA(1, 0), cA + kstep, voffA); PG8_STAGE(PG8_SB(1, 1), cB + hstep + kstep, voffB);
    PG8_WAIT_V(6); PG8_BAR;
    PG8_STAMP();
    for (;;) {
        const bool has_next = S.next(ui + 1, nxt);
        const char* nA = has_next ? (const char*)g.A + (size_t)nxt.pm * tstep : cA; const char* nB = has_next ? (const char*)g.Bt + (size_t)nxt.pn * tstep : cB;
        for (int t = 0; t < nt; t += 2) {
            const bool last = (t == nt - 2);
            const char* a1 = cA + (size_t)(t + 1) * kstep;
            const char* a2 = last ? nA : cA + (size_t)(t + 2) * kstep; const char* b2 = last ? nB : cB + (size_t)(t + 2) * kstep;
            const char* a3 = a2 + kstep; const char* b3 = b2 + kstep;
            if (last && has_next) S.a_ready(nxt);
            PG8_LDB(B0, 0, 0); PG8_SCHED; PG8_LDA(At, 0, 0); PG8_STAGE(PG8_SA(1, 1), a1 + hstep, voffA);
            PG8_WAIT_L(8); PG8_BAR; PG8_WAIT_L(0); PG8_MMA(0, 0, At, B0); PG8_BAR; PG8_SCHED;
            PG8_LDB(B1, 0, 1); PG8_STAGE(PG8_SB(0, 0), b2, voffB);
            PG8_BAR; PG8_WAIT_L(0); PG8_MMA(0, 1, At, B1); PG8_BAR;
            PG8_LDA(At, 0, 1); PG8_STAGE(PG8_SA(0, 0), a2, voffA);
            PG8_BAR; PG8_WAIT_L(0); PG8_MMA(1, 0, At, B0); PG8_BAR; PG8_SCHED;
            PG8_STAGE(PG8_SB(0, 1), b2 + hstep, voffB);
            PG8_WAIT_V(6); PG8_BAR; PG8_MMA(1, 1, At, B1); PG8_BAR;
            PG8_LDB(B0, 1, 0); PG8_SCHED; PG8_LDA(At, 1, 0); PG8_STAGE(PG8_SA(0, 1), a2 + hstep, voffA);
            PG8_WAIT_L(8); PG8_BAR; PG8_WAIT_L(0); PG8_MMA(0, 0, At, B0); PG8_BAR; PG8_SCHED;
            PG8_LDB(B1, 1, 1); PG8_STAGE(PG8_SB(1, 0), b3, voffB);
            PG8_BAR; PG8_WAIT_L(0); PG8_MMA(0, 1, At, B1); PG8_BAR;
            PG8_LDA(At, 1, 1); PG8_STAGE(PG8_SA(1, 0), a3, voffA);
            PG8_BAR; PG8_WAIT_L(0); PG8_MMA(1, 0, At, B0); PG8_BAR; PG8_SCHED;
            PG8_STAGE(PG8_SB(1, 1), b3 + hstep, voffB);
            PG8_WAIT_V(6); PG8_BAR; PG8_MMA(1, 1, At, B1); PG8_BAR;
        }
        PG8_STAMP();
        if constexpr (!Epi::AFTER_DRAIN) { E(acc, cur, wr, wc, fr, fq); S.done(cur); }
        PG8_STAMP();
        if (!has_next) break;
#pragma unroll
        for (int a = 0; a < 2; ++a)
#pragma unroll
            for (int b = 0; b < 2; ++b)
#pragma unroll
                for (int m = 0; m < 4; ++m)
#pragma unroll
                    for (int n = 0; n < 2; ++n) acc[a][b][m][n] = (f32x4){0.f, 0.f, 0.f, 0.f};
        cur = nxt; cA = nA; cB = nB; ++ui;
    }
    PG8_WAIT_V(0);
    if (wr == 0) PG8_BAR;
    PG8_BAR;
    if constexpr (Epi::AFTER_DRAIN) { E.fused(acc, cur, wr, wc, fr, fq, lds, wid, lane); S.done(cur); }
    PG8_STAMP();
    if (STAMP && wid == 0) { stamps[lane] = lane < nts ? (((unsigned long long)(unsigned)ts_hi << 32) | (unsigned)ts_lo) : 0ull;
        if (lane == 62) stamps[62] = rt_entry; if (lane == 63) stamps[63] = (unsigned long long)wall_clock64(); }
#undef PG8_STAMP
#undef PG8_SA
#undef PG8_SB
#undef PG8_STAGE
#undef PG8_LDA
#undef PG8_LDB
#undef PG8_MMA
#undef PG8_WAIT_V
#undef PG8_WAIT_L
#undef PG8_BAR
#undef PG8_SCHED
}
}

namespace cg = cooperative_groups;
using pg8::bf16_t; using pg8::bf16x8; using pg8::f32x4; using pg8::u32x4; using pg8::cvt_pk_bf16;
typedef unsigned u32x2 __attribute__((ext_vector_type(2)));

constexpr int DM = 2048, NTOK = 9216, NPT = 8192, SEQ = 2048, PIN = 10496, RWW = 768, RWP = 2560, DFF = 5632;
constexpr int C_QSW = 2560, C_KSW = 3328, C_VSW = 3584, C_QMEM = 3840, C_GATE = 4352;
constexpr int LDS_BYTES = 147456;
constexpr float NEPS = 1e-6f;

constexpr size_t WS_WT_IN = 0;
constexpr size_t WS_WT_MEMKV = WS_WT_IN + (size_t)PIN * DM * 2;
constexpr size_t WS_WT_LR = WS_WT_MEMKV + (size_t)1024 * DM * 2;
constexpr size_t WS_WT_BR0 = WS_WT_LR + (size_t)2304 * 256 * 2;
constexpr size_t WS_WT_BR1 = WS_WT_BR0 + (size_t)DM * 768 * 2;
constexpr size_t WS_WT_BR2 = WS_WT_BR1 + (size_t)DM * 768 * 2;
constexpr size_t WS_WT_O = WS_WT_BR2 + (size_t)DM * 512 * 2;
constexpr size_t WS_XN = WS_WT_O + (size_t)DM * DM * 2;
constexpr size_t WS_MEMN = WS_XN + (size_t)NTOK * DM * 2;
constexpr size_t WS_MEMKV = WS_MEMN + (size_t)1024 * DM * 2;
constexpr size_t WS_ALR = WS_MEMKV + (size_t)1024 * 1024 * 2;
constexpr size_t WS_WT_UP = WS_ALR + (size_t)NTOK * 256 * 2;
constexpr size_t WS_WT_DN = WS_WT_UP + (size_t)2 * DFF * DM * 2;
constexpr size_t WS_BIG = WS_WT_DN + (size_t)DM * DFF * 2;
constexpr size_t WS_H = WS_BIG + (size_t)NTOK * 2 * DFF * 2;
constexpr size_t WS_MRG = WS_H + (size_t)NTOK * DM * 4;
constexpr size_t WS_END = WS_MRG + (size_t)NTOK * DM * 4;
constexpr size_t WS_ACT = 0;
constexpr size_t WS_ORW = WS_WT_IN;
constexpr size_t WS_OSW = WS_ORW + (size_t)NTOK * 768 * 2;
constexpr size_t WS_OMEM = WS_OSW + (size_t)NTOK * 768 * 2;
constexpr size_t WS_MERGEDB = WS_XN;
constexpr size_t WS_LRO = WS_H;
constexpr size_t WS_ORAW = WS_MRG;
constexpr size_t WS_BONUS = WS_ORAW + (size_t)NTOK * 768 * 4;
static_assert(WS_ACT + (size_t)NTOK * DFF * 2 <= WS_WT_UP, "ACT alias");
static_assert(WS_OMEM + (size_t)NTOK * 512 * 2 <= WS_WT_MEMKV, "O alias");
static_assert(WS_BONUS + (size_t)NTOK * 12 * 4 <= WS_END, "bonus alias");

constexpr size_t O_Y = 0;
constexpr size_t O_SWAK_P = (size_t)NTOK * DM;
constexpr size_t O_SWAV_P = O_SWAK_P + 131072;
constexpr size_t O_MEMK_P = O_SWAV_P + 131072;
constexpr size_t O_MEMV_P = O_MEMK_P + 524288;
constexpr size_t O_SHIFT_P = O_MEMV_P + 524288;
constexpr size_t O_WKV_P = O_SHIFT_P + 10240;
constexpr size_t O_CONV_P = O_WKV_P + 196608;
constexpr size_t O_SWAK_S = O_CONV_P + 45056;
constexpr size_t O_SWAV_S = O_SWAK_S + 4194304;
constexpr size_t O_SHIFT_S = O_SWAV_S + 4194304;
constexpr size_t O_WKV_S = O_SHIFT_S + 327680;
constexpr size_t O_CONV_S = O_WKV_S + 6291456;
constexpr size_t O_END = O_CONV_S + 1441792;

struct KArgs { const float* in[37]; float* out; unsigned char* ws; };

__device__ __forceinline__ float bflo(unsigned u) { return __uint_as_float(u << 16); }
__device__ __forceinline__ float bfhi(unsigned u) { return __uint_as_float(u & 0xffff0000u); }
__device__ __forceinline__ float bf2f(bf16_t b) { return __uint_as_float(((unsigned)b) << 16); }
__device__ __forceinline__ bf16_t f2bf(float f) { return (bf16_t)(cvt_pk_bf16(f, 0.f) & 0xffffu); }
__device__ __forceinline__ float sigmoidf_(float v) { return 1.f / (1.f + __expf(-v)); }
#define DPP_ADD(v, ctrl) v += __int_as_float(__builtin_amdgcn_update_dpp(0, __float_as_int(v), ctrl, 0xF, 0xF, false))
__device__ __forceinline__ float rowsum16(float v) { DPP_ADD(v, 0xB1); DPP_ADD(v, 0x4E); DPP_ADD(v, 0x141); DPP_ADD(v, 0x140); return v; }
__device__ __forceinline__ float wave_sum(float v) { v = rowsum16(v); v += __shfl_xor(v, 16); v += __shfl_xor(v, 32); return v; }
__device__ __forceinline__ void lds_fence() { asm volatile("s_waitcnt lgkmcnt(0)" ::: "memory"); }

struct EpiF32 {
    static constexpr bool PERM = false, AFTER_DRAIN = false;
    float* C; int ldc;
    __device__ __forceinline__ void operator()(const f32x4 (&acc)[2][2][4][2], const pg8::Unit& u, int wr, int wc, int fr, int fq) const {
        const int row0 = u.pm * 256 + wr * 64 + fr, col0 = u.pn * 256 + wc * 32 + 4 * fq;
#pragma unroll
        for (int ai = 0; ai < 2; ++ai)
#pragma unroll
            for (int m = 0; m < 4; ++m) { float* rowp = C + (size_t)(row0 + ai * 128 + m * 16) * ldc + col0;
#pragma unroll
                for (int bj = 0; bj < 2; ++bj)
#pragma unroll
                    for (int n = 0; n < 2; ++n) *(f32x4*)(rowp + bj * 128 + n * 16) = acc[ai][bj][m][n]; }
    }
};
struct EpiB16 {
    static constexpr bool PERM = true, AFTER_DRAIN = false;
    bf16_t* O; int ldc; int sig_pn;
    __device__ __forceinline__ void operator()(const f32x4 (&acc)[2][2][4][2], const pg8::Unit& u, int wr, int wc, int fr, int fq) const {
        const int row0 = u.pm * 256 + wr * 64 + fr, col0 = u.pn * 256 + wc * 32 + 8 * fq;
        const bool sig = u.pn >= sig_pn;
#pragma unroll
        for (int ai = 0; ai < 2; ++ai)
#pragma unroll
            for (int m = 0; m < 4; ++m) { bf16_t* rowp = O + (size_t)(row0 + ai * 128 + m * 16) * ldc + col0;
#pragma unroll
                for (int bj = 0; bj < 2; ++bj) { f32x4 v0 = acc[ai][bj][m][0], v1 = acc[ai][bj][m][1];
                    if (sig) {
#pragma unroll
                        for (int j = 0; j < 4; ++j) { v0[j] = sigmoidf_(v0[j]); v1[j] = sigmoidf_(v1[j]); } }
                    u32x4 w; w.x = cvt_pk_bf16(v0[0], v0[1]); w.y = cvt_pk_bf16(v0[2], v0[3]); w.z = cvt_pk_bf16(v1[0], v1[1]); w.w = cvt_pk_bf16(v1[2], v1[3]);
                    *(u32x4*)(rowp + bj * 128) = w; } }
    }
};
struct EpiMemKV {
    static constexpr bool PERM = true, AFTER_DRAIN = false;
    float* OK; float* OV; bf16_t* B;
    __device__ __forceinline__ void operator()(const f32x4 (&acc)[2][2][4][2], const pg8::Unit& u, int wr, int wc, int fr, int fq) const {
        const int row0 = u.pm * 256 + wr * 64 + fr, col0 = u.pn * 256 + wc * 32 + 8 * fq;
        float* F = (u.pn >= 2) ? OV : OK; const int fcol0 = col0 & 511;
#pragma unroll
        for (int ai = 0; ai < 2; ++ai)
#pragma unroll
            for (int m = 0; m < 4; ++m) { const int row = row0 + ai * 128 + m * 16;
#pragma unroll
                for (int bj = 0; bj < 2; ++bj) { const f32x4 v0 = acc[ai][bj][m][0], v1 = acc[ai][bj][m][1];
                    *(f32x4*)(F + (size_t)row * 512 + fcol0 + bj * 128) = v0; *(f32x4*)(F + (size_t)row * 512 + fcol0 + bj * 128 + 4) = v1;
                    u32x4 w; w.x = cvt_pk_bf16(v0[0], v0[1]); w.y = cvt_pk_bf16(v0[2], v0[3]); w.z = cvt_pk_bf16(v1[0], v1[1]); w.w = cvt_pk_bf16(v1[2], v1[3]);
                    *(u32x4*)(B + (size_t)row * 1024 + col0 + bj * 128) = w; } }
    }
};
template <int MODE> struct EpiBr {
    static constexpr bool PERM = false, AFTER_DRAIN = false;
    float* MG; bf16_t* MB; const bf16_t* GATE;
    __device__ __forceinline__ void operator()(const f32x4 (&acc)[2][2][4][2], const pg8::Unit& u, int wr, int wc, int fr, int fq) const {
        const int row0 = u.pm * 256 + wr * 64 + fr, col0 = u.pn * 256 + wc * 32 + 4 * fq;
#pragma unroll
        for (int ai = 0; ai < 2; ++ai)
#pragma unroll
            for (int m = 0; m < 4; ++m) { const size_t row = (size_t)(row0 + ai * 128 + m * 16);
#pragma unroll
                for (int bj = 0; bj < 2; ++bj)
#pragma unroll
                    for (int n = 0; n < 2; ++n) { const int c = col0 + bj * 128 + n * 16;
                        const u32x2 gw = *(const u32x2*)(GATE + row * PIN + c);
                        f32x4 v = acc[ai][bj][m][n]; v[0] *= bflo(gw.x); v[1] *= bfhi(gw.x); v[2] *= bflo(gw.y); v[3] *= bfhi(gw.y);
                        if (MODE >= 1) v += *(const f32x4*)(MG + row * DM + c);
                        if (MODE <= 1) *(f32x4*)(MG + row * DM + c) = v;
                        else { u32x2 w; w.x = cvt_pk_bf16(v[0], v[1]); w.y = cvt_pk_bf16(v[2], v[3]); *(u32x2*)(MB + row * DM + c) = w; } } }
    }
};

__device__ __forceinline__ void transpose_item(const float* __restrict__ W, int K, int N, bf16_t* __restrict__ WT, float* scr, int item, int lane) {
    const int nblk = N / 32, kb = item / nblk, nb = item % nblk, k0 = 64 * kb, n0 = 32 * nb;
#pragma unroll 8
    for (int i = 0; i < 32; ++i) { const int kk = 2 * i + (lane >> 5); scr[kk * 33 + (lane & 31)] = W[(size_t)(k0 + kk) * N + n0 + (lane & 31)]; }
    lds_fence();
    const int c = lane & 7;
#pragma unroll
    for (int j = 0; j < 4; ++j) { const int n = (lane >> 3) + 8 * j; const float* s = scr + (8 * c) * 33 + n;
        u32x4 o; o.x = cvt_pk_bf16(s[0 * 33], s[1 * 33]); o.y = cvt_pk_bf16(s[2 * 33], s[3 * 33]); o.z = cvt_pk_bf16(s[4 * 33], s[5 * 33]); o.w = cvt_pk_bf16(s[6 * 33], s[7 * 33]);
        *(u32x4*)(WT + (size_t)(n0 + n) * K + k0 + 8 * c) = o; }
    lds_fence();
}
__device__ __forceinline__ void rms_row_to_bf16(const float* __restrict__ xrow, const float* __restrict__ g, bf16_t* __restrict__ orow, int lane) {
    const f32x4* xr = (const f32x4*)xrow + lane; const f32x4* gr = (const f32x4*)g + lane;
    f32x4 v[8]; float s = 0.f;
#pragma unroll
    for (int j = 0; j < 8; ++j) { v[j] = xr[64 * j]; s += (v[j][0] * v[j][0] + v[j][1] * v[j][1]) + (v[j][2] * v[j][2] + v[j][3] * v[j][3]); }
    const float rs = rsqrtf(wave_sum(s) * (1.f / DM) + NEPS);
    u32x2* o8 = (u32x2*)orow + lane;
#pragma unroll
    for (int j = 0; j < 8; ++j) { const f32x4 gg = gr[64 * j]; u32x2 w; w.x = cvt_pk_bf16(v[j][0] * rs * gg[0], v[j][1] * rs * gg[1]); w.y = cvt_pk_bf16(v[j][2] * rs * gg[2], v[j][3] * rs * gg[3]); o8[64 * j] = w; }
}
__device__ __forceinline__ const float* xrow_ptr(const KArgs& a, int tok) { return tok < NPT ? a.in[0] + (size_t)tok * DM : a.in[1] + (size_t)(tok - NPT) * DM; }

__device__ __forceinline__ void phase0(const KArgs& a, unsigned char* lds, int tid, int wave, int lane) {
    unsigned char* ws = a.ws;
    float* scr = (float*)(lds + wave * 8704);
    const int gw = blockIdx.x * 8 + wave, NGW = gridDim.x * 8;
    constexpr int I_IN = 32 * (PIN / 32), I_MKV = 32 * 32, I_BR = 12 * 64, I_BR2 = 8 * 64, I_O = 32 * 64, I_UP = 32 * (2 * DFF / 32), I_DN = (DFF / 64) * 64;
    constexpr int NITEMS = I_IN + I_MKV + 2 * I_BR + I_BR2 + I_O + I_UP + I_DN;
    for (int it = gw; it < NITEMS; it += NGW) {
        int r = it;
        if (r < I_IN) { transpose_item(a.in[11], DM, PIN, (bf16_t*)(ws + WS_WT_IN), scr, r, lane); continue; } r -= I_IN;
        if (r < I_MKV) { transpose_item(a.in[25], DM, 1024, (bf16_t*)(ws + WS_WT_MEMKV), scr, r, lane); continue; } r -= I_MKV;
        if (r < I_BR) { transpose_item(a.in[26], 768, DM, (bf16_t*)(ws + WS_WT_BR0), scr, r, lane); continue; } r -= I_BR;
        if (r < I_BR) { transpose_item(a.in[27], 768, DM, (bf16_t*)(ws + WS_WT_BR1), scr, r, lane); continue; } r -= I_BR;
        if (r < I_BR2) { transpose_item(a.in[28], 512, DM, (bf16_t*)(ws + WS_WT_BR2), scr, r, lane); continue; } r -= I_BR2;
        if (r < I_O) { transpose_item(a.in[29], DM, DM, (bf16_t*)(ws + WS_WT_O), scr, r, lane); continue; } r -= I_O;
        if (r < I_UP) { transpose_item(a.in[32], DM, 2 * DFF, (bf16_t*)(ws + WS_WT_UP), scr, r, lane); continue; } r -= I_UP;
        transpose_item(a.in[35], DFF, DM, (bf16_t*)(ws + WS_WT_DN), scr, r, lane);
    }
    { bf16_t* wl = (bf16_t*)(ws + WS_WT_LR);
      for (int i = blockIdx.x * 512 + tid; i < 2304 * 256; i += gridDim.x * 512) { const int n = i >> 8, k = i & 255; float v = 0.f;
          if (n < 768) { if (k < 64) v = a.in[13][k * 768 + n]; }
          else if (n < 1536) { if (k >= 64 && k < 128) v = a.in[15][(k - 64) * 768 + (n - 768)]; }
          else { if (k >= 128) v = a.in[17][(k - 128) * 768 + (n - 1536)]; }
          wl[i] = f2bf(v); } }
    for (int m = gw; m < NTOK + 1024; m += NGW) {
        if (m < NTOK) rms_row_to_bf16(xrow_ptr(a, m), a.in[10], (bf16_t*)(ws + WS_XN) + (size_t)m * DM, lane);
        else rms_row_to_bf16(a.in[9] + (size_t)(m - NTOK) * DM, a.in[24], (bf16_t*)(ws + WS_MEMN) + (size_t)(m - NTOK) * DM, lane);
    }
}

template <int D, int NKB>
__device__ __forceinline__ void attn_wave(const unsigned char* Ks, int kpitch, const unsigned char* VTs, int vpitch, int kb_lo,
                                          const bf16_t* qptr, float scale, int lo, int hi, float sink, bool use_sink, bf16_t* optr, bool store, int lane) {
    const int l15 = lane & 15, q4 = lane >> 4;
    const float NINF = -__builtin_inff();
    bf16x8 qf[D / 32];
#pragma unroll
    for (int ks = 0; ks < D / 32; ++ks) qf[ks] = *(const bf16x8*)(qptr + ks * 32 + q4 * 8);
    f32x4 s[NKB];
#pragma unroll
    for (int kb = 0; kb < NKB; ++kb) { f32x4 acc = (f32x4){0.f, 0.f, 0.f, 0.f};
#pragma unroll
        for (int ks = 0; ks < D / 32; ++ks) { const bf16x8 kf = *(const bf16x8*)(Ks + (size_t)((kb_lo + kb) * 16 + l15) * kpitch + (ks * 32 + q4 * 8) * 2);
            acc = __builtin_amdgcn_mfma_f32_16x16x32_bf16(kf, qf[ks], acc, 0, 0, 0); }
        s[kb] = acc; }
    float m = use_sink ? sink : NINF;
#pragma unroll
    for (int kb = 0; kb < NKB; ++kb)
#pragma unroll
        for (int r = 0; r < 4; ++r) { const int j = (kb_lo + kb) * 16 + q4 * 4 + r; float v = s[kb][r] * scale; v = (j >= lo && j <= hi) ? v : NINF; s[kb][r] = v; m = fmaxf(m, v); }
    m = fmaxf(m, __shfl_xor(m, 16)); m = fmaxf(m, __shfl_xor(m, 32));
    if (m == NINF) m = 0.f;
    float sum = 0.f;
#pragma unroll
    for (int kb = 0; kb < NKB; ++kb)
#pragma unroll
        for (int r = 0; r < 4; ++r) { const float e = __expf(s[kb][r] - m); s[kb][r] = e; sum += e; }
    sum += __shfl_xor(sum, 16); sum += __shfl_xor(sum, 32);
    if (use_sink) sum += __expf(sink - m);
    const float inv = 1.f / sum;
    f32x4 o[D / 16];
#pragma unroll
    for (int db = 0; db < D / 16; ++db) o[db] = (f32x4){0.f, 0.f, 0.f, 0.f};
#pragma unroll
    for (int pr = 0; pr < NKB / 2; ++pr) {
        u32x4 pw; pw.x = cvt_pk_bf16(s[2 * pr][0], s[2 * pr][1]); pw.y = cvt_pk_bf16(s[2 * pr][2], s[2 * pr][3]);
        pw.z = cvt_pk_bf16(s[2 * pr + 1][0], s[2 * pr + 1][1]); pw.w = cvt_pk_bf16(s[2 * pr + 1][2], s[2 * pr + 1][3]);
        const bf16x8 pf = __builtin_bit_cast(bf16x8, pw);
#pragma unroll
        for (int db = 0; db < D / 16; ++db) { const unsigned char* vp = VTs + (size_t)(db * 16 + l15) * vpitch + ((kb_lo + 2 * pr) * 16 + q4 * 4) * 2;
            const u32x2 v0 = *(const u32x2*)vp, v1 = *(const u32x2*)(vp + 32);
            u32x4 vw; vw.x = v0.x; vw.y = v0.y; vw.z = v1.x; vw.w = v1.y;
            o[db] = __builtin_amdgcn_mfma_f32_16x16x32_bf16(__builtin_bit_cast(bf16x8, vw), pf, o[db], 0, 0, 0); } }
    if (store) {
#pragma unroll
        for (int db = 0; db < D / 16; ++db) { u32x2 w; w.x = cvt_pk_bf16(o[db][0] * inv, o[db][1] * inv); w.y = cvt_pk_bf16(o[db][2] * inv, o[db][3] * inv);
            *(u32x2*)(optr + db * 16 + q4 * 4) = w; } }
}
__device__ __forceinline__ void vt_write8(unsigned char* VTs, int vpitch, int key, int d0, u32x4 w) {
    unsigned short* p = (unsigned short*)(VTs + (size_t)d0 * vpitch + key * 2); const int st = vpitch >> 1;
    p[0] = (unsigned short)(w.x & 0xffffu); p[st] = (unsigned short)(w.x >> 16); p[2 * st] = (unsigned short)(w.y & 0xffffu); p[3 * st] = (unsigned short)(w.y >> 16);
    p[4 * st] = (unsigned short)(w.z & 0xffffu); p[5 * st] = (unsigned short)(w.z >> 16); p[6 * st] = (unsigned short)(w.w & 0xffffu); p[7 * st] = (unsigned short)(w.w >> 16);
}
__device__ __forceinline__ u32x4 pack8(const f32x4 a, const f32x4 b) { u32x4 w; w.x = cvt_pk_bf16(a[0], a[1]); w.y = cvt_pk_bf16(a[2], a[3]); w.z = cvt_pk_bf16(b[0], b[1]); w.w = cvt_pk_bf16(b[2], b[3]); return w; }

constexpr int KP64 = 144, KP128 = 272, VTP = 544;
constexpr int VT_OFF64 = 256 * KP64, VT_OFF128 = 256 * KP128;

__device__ __forceinline__ void phase2(const KArgs& a, unsigned char* lds, int tid, int wave, int lane) {
    unsigned char* ws = a.ws;
    const bf16_t* P = (const bf16_t*)(ws + WS_BIG);
    bf16_t* OSW = (bf16_t*)(ws + WS_OSW); bf16_t* OMEM = (bf16_t*)(ws + WS_OMEM);
    const bf16_t* MEMKV = (const bf16_t*)(ws + WS_MEMKV);
    const float* sinks = a.in[23];
    const u32x4 zero4 = (u32x4){0u, 0u, 0u, 0u};
    for (int u = blockIdx.x; u < 256; u += gridDim.x) {
        const int b = u >> 6, kvh = (u >> 4) & 3, qb = u & 15;
        unsigned char* Ks = lds; unsigned char* VTs = lds + VT_OFF64;
#pragma unroll
        for (int it = 0; it < 4; ++it) { const int ch = tid + it * 512, j = ch >> 3, c8 = ch & 7; const int pos = qb * 128 - 128 + j; const bool ok = pos >= 0;
            const bf16_t* src = P + (size_t)(b * SEQ + (ok ? pos : 0)) * PIN + kvh * 64 + c8 * 8;
            u32x4 kv = *(const u32x4*)(src + C_KSW), vv = *(const u32x4*)(src + C_VSW);
            if (!ok) { kv = zero4; vv = zero4; }
            *(u32x4*)(Ks + j * KP64 + c8 * 16) = kv; vt_write8(VTs, VTP, j, c8 * 8, vv); }
        __syncthreads();
        const int qi = wave * 16 + (lane & 15); const int tok = b * SEQ + qb * 128 + qi;
        const int lo = (qb == 0) ? (qi + 1 > 128 ? qi + 1 : 128) : qi + 1, hi = qi + 128;
        const int kb_lo = wave < 6 ? wave : 6;
#pragma unroll 1
        for (int g = 0; g < 3; ++g) { const int hq = kvh * 3 + g;
            attn_wave<64, 10>(Ks, KP64, VTs, VTP, kb_lo, P + (size_t)tok * PIN + C_QSW + hq * 64, 0.125f, lo, hi, sinks[hq], true, OSW + (size_t)tok * 768 + hq * 64, true, lane); }
        __syncthreads();
    }
    for (int u = blockIdx.x; u < 512; u += gridDim.x) {
        const int b = u >> 2, kvh = u & 3;
        unsigned char* Ks = lds; unsigned char* VTs = lds + VT_OFF64;
#pragma unroll
        for (int it = 0; it < 3; ++it) { const int ch = tid + it * 512;
            if (ch < 1280) { const int j = ch >> 3, c8 = ch & 7; u32x4 kv = zero4, vv = zero4;
                if (j < 128) { const size_t off = ((size_t)(b * 128 + j) * 4 + kvh) * 64 + c8 * 8;
                    kv = pack8(*(const f32x4*)(a.in[2] + off), *(const f32x4*)(a.in[2] + off + 4)); vv = pack8(*(const f32x4*)(a.in[3] + off), *(const f32x4*)(a.in[3] + off + 4)); }
                else if (j < 136) { const bf16_t* src = P + (size_t)(NPT + b * 8 + (j - 128)) * PIN + kvh * 64 + c8 * 8; kv = *(const u32x4*)(src + C_KSW); vv = *(const u32x4*)(src + C_VSW); }
                *(u32x4*)(Ks + j * KP64 + c8 * 16) = kv; vt_write8(VTs, VTP, j, c8 * 8, vv); } }
        __syncthreads();
        if (wave < 3) { const int t = lane & 15, tc = t < 8 ? t : 7; const int hq = kvh * 3 + wave; const int tok = NPT + b * 8 + tc;
            attn_wave<64, 10>(Ks, KP64, VTs, VTP, 0, P + (size_t)tok * PIN + C_QSW + hq * 64, 0.125f, tc + 1, tc + 128, sinks[hq], true, OSW + (size_t)tok * 768 + hq * 64, t < 8, lane); }
        __syncthreads();
    }
    for (int u = blockIdx.x; u < 256; u += gridDim.x) {
        const int b = u >> 6, h = (u >> 4) & 3, qb = u & 15;
        unsigned char* Ks = lds; unsigned char* VTs = lds + VT_OFF128;
#pragma unroll
        for (int it = 0; it < 8; ++it) { const int ch = tid + it * 512, j = ch >> 4, c8 = ch & 15;
            const bf16_t* src = MEMKV + (size_t)(b * 256 + j) * 1024 + h * 128 + c8 * 8;
            const u32x4 kv = *(const u32x4*)src, vv = *(const u32x4*)(src + 512);
            *(u32x4*)(Ks + j * KP128 + c8 * 16) = kv; vt_write8(VTs, VTP, j, c8 * 8, vv); }
        __syncthreads();
        const int tok = b * SEQ + qb * 128 + wave * 16 + (lane & 15);
        attn_wave<128, 16>(Ks, KP128, VTs, VTP, 0, P + (size_t)tok * PIN + C_QMEM + h * 128, 0.08838834764831845f, 0, 255, 0.f, false, OMEM + (size_t)tok * 512 + h * 128, true, lane);
        __syncthreads();
    }
    for (int u = blockIdx.x; u < 512; u += gridDim.x) {
        const int b = u >> 2, h = u & 3;
        unsigned char* Ks = lds; unsigned char* VTs = lds + VT_OFF128;
#pragma unroll 2
        for (int it = 0; it < 8; ++it) { const int ch = tid + it * 512, j = ch >> 4, c8 = ch & 15;
            const size_t off = ((size_t)(b * 256 + j) * 4 + h) * 128 + c8 * 8;
            const u32x4 kv = pack8(*(const f32x4*)(a.in[4] + off), *(const f32x4*)(a.in[4] + off + 4)), vv = pack8(*(const f32x4*)(a.in[5] + off), *(const f32x4*)(a.in[5] + off + 4));
            *(u32x4*)(Ks + j * KP128 + c8 * 16) = kv; vt_write8(VTs, VTP, j, c8 * 8, vv); }
        __syncthreads();
        if (wave == 0) { const int t = lane & 15, tc = t < 8 ? t : 7; const int tok = NPT + b * 8 + tc;
            attn_wave<128, 16>(Ks, KP128, VTs, VTP, 0, P + (size_t)tok * PIN + C_QMEM + h * 128, 0.08838834764831845f, 0, 255, 0.f, false, OMEM + (size_t)tok * 512 + h * 128, t < 8, lane); }
        __syncthreads();
    }
    { bf16_t* ALR = (bf16_t*)(ws + WS_ALR); const float* mu = a.in[12];
      for (int i = blockIdx.x * 512 + tid; i < NTOK * 256; i += gridDim.x * 512) { const int tok = i >> 8, c = i & 255, col = 2304 + c;
          const float p = bf2f(P[(size_t)tok * PIN + col]); float prev;
          if (tok < NPT) prev = (tok & (SEQ - 1)) ? bf2f(P[(size_t)(tok - 1) * PIN + col]) : 0.f;
          else { const int st = tok - NPT; prev = (st & 7) ? bf2f(P[(size_t)(tok - 1) * PIN + col]) : a.in[6][(size_t)(st >> 3) * RWP + col]; }
          const float s = p + mu[col] * (prev - p);
          float v; if (c < 64) v = tanhf(s); else if (c < 128) v = s; else v = sigmoidf_(s);
          ALR[i] = f2bf(v); } }
    { float* out = a.out; const int gt = blockIdx.x * 512 + tid, GT = gridDim.x * 512;
      for (int i = gt; i < 131072; i += GT) { const int b = i >> 15, r = (i >> 8) & 127, c = i & 255; const size_t src = (size_t)(b * SEQ + 1920 + r) * PIN + c;
          out[O_SWAK_P + i] = bf2f(P[src + C_KSW]); out[O_SWAV_P + i] = bf2f(P[src + C_VSW]); }
      for (int i = gt; i < 4194304; i += GT) { const int b = i >> 15, r = (i >> 8) & 127, c = i & 255; float kv, vv;
          if (r < 120) { kv = a.in[2][(size_t)(b * 128 + r + 8) * 256 + c]; vv = a.in[3][(size_t)(b * 128 + r + 8) * 256 + c]; }
          else { const size_t src = (size_t)(NPT + b * 8 + (r - 120)) * PIN + c; kv = bf2f(P[src + C_KSW]); vv = bf2f(P[src + C_VSW]); }
          out[O_SWAK_S + i] = kv; out[O_SWAV_S + i] = vv; }
      for (int i = gt; i < 4 * RWP; i += GT) { const int b = i / RWP, c = i - b * RWP; out[O_SHIFT_P + i] = bf2f(P[(size_t)(b * SEQ + SEQ - 1) * PIN + c]); }
      for (int i = gt; i < 128 * RWP; i += GT) { const int b = i / RWP, c = i - b * RWP; out[O_SHIFT_S + i] = bf2f(P[(size_t)(NPT + b * 8 + 7) * PIN + c]); } }
}

constexpr int TC = 32;
constexpr int SCAN_BUF_FLOATS = TC * 320 + TC * 16 + 1024;
constexpr int SCAN_OUT_OFF = 2 * SCAN_BUF_FLOATS * 4;

struct SUnit { int tok0, len, b, h, rb; bool first, last, prompt; };
__device__ __forceinline__ SUnit scan_unit(int blk, int u) {
    SUnit s;
    if (blk < 192) { const int bh = blk >> 2; s.b = bh / 12; s.h = bh - s.b * 12; s.rb = blk & 3; s.tok0 = s.b * SEQ + u * TC; s.len = TC; s.first = (u == 0); s.last = (u == SEQ / TC - 1); s.prompt = true; }
    else { const int task = (blk - 192) * 96 + u, seq = task >> 2; s.b = seq / 12; s.h = seq - s.b * 12; s.rb = task & 3; s.tok0 = NPT + s.b * 8; s.len = 8; s.first = true; s.last = true; s.prompt = false; }
    return s;
}
__device__ __forceinline__ void scan_prep(const KArgs& a, const SUnit& s, float* buf, int lw, int lane, int ltid) {
    const unsigned char* ws = a.ws;
    const bf16_t* P = (const bf16_t*)(ws + WS_BIG); const bf16_t* LRO = (const bf16_t*)(ws + WS_LRO);
    float* BON = (float*)(ws + WS_BONUS);
    const int ch = s.h * 64 + lane;
    const float w0c = a.in[14][ch], a0c = a.in[16][ch];
    const float mu_r = a.in[12][ch], mu_k = a.in[12][768 + ch], mu_v = a.in[12][1536 + ch], kkc = a.in[18][ch], kac = a.in[19][ch], rkc = a.in[20][ch];
    float pr[8], pk[8], pv[8], qr[8], qk[8], qv[8], de[8], aa[8];
#pragma unroll
    for (int i = 0; i < 8; ++i) { const int tt = lw + 4 * i; const int ttc = tt < s.len ? tt : 0; const int tok = s.tok0 + ttc; const bool is0 = s.first && ttc == 0;
        const bf16_t* row = P + (size_t)tok * PIN + ch; const bf16_t* rowm = P + (size_t)(is0 ? tok : tok - 1) * PIN + ch;
        pr[i] = bf2f(row[0]); pk[i] = bf2f(row[768]); pv[i] = bf2f(row[1536]);
        qr[i] = bf2f(rowm[0]); qk[i] = bf2f(rowm[768]); qv[i] = bf2f(rowm[1536]);
        if (is0) { if (s.prompt) { qr[i] = 0.f; qk[i] = 0.f; qv[i] = 0.f; } else { const float* sh = a.in[6] + (size_t)s.b * RWP + ch; qr[i] = sh[0]; qk[i] = sh[768]; qv[i] = sh[1536]; } }
        de[i] = bf2f(LRO[(size_t)tok * 2304 + ch]); aa[i] = bf2f(LRO[(size_t)tok * 2304 + 768 + ch]); }
    if (!s.prompt) { const f32x4 st = *(const f32x4*)(a.in[7] + ((size_t)(s.b * 12 + s.h) * 64 + s.rb * 16) * 64 + ltid * 4); *(f32x4*)(buf + TC * 336 + ltid * 4) = st; }
#pragma unroll
    for (int i = 0; i < 8; ++i) { const int tt = lw + 4 * i;
        if (tt < s.len) { const int tok = s.tok0 + tt;
            { const float x = w0c + de[i]; const float sp = fmaxf(-x, 0.f) + __logf(1.f + __expf(-fabsf(x))); de[i] = __expf(-__expf(-sp - 0.5f)); aa[i] = sigmoidf_(a0c + aa[i]); }
            const float sr = pr[i] + mu_r * (qr[i] - pr[i]), sk = pk[i] + mu_k * (qk[i] - pk[i]), sv = pv[i] + mu_v * (qv[i] - pv[i]);
            const float kk = sk * kkc; const float n2 = wave_sum(kk * kk); const float kkn = kk / fmaxf(sqrtf(n2), 1e-12f);
            const float kq = sk * (1.f + (aa[i] - 1.f) * kac);
            float* vb = buf + tt * 320;
            vb[lane] = de[i]; vb[64 + lane] = -kkn; vb[128 + lane] = kkn * aa[i]; vb[192 + lane] = kq; vb[256 + lane] = sr;
            if ((lane >> 4) == s.rb) buf[TC * 320 + tt * 16 + (lane & 15)] = sv;
            if (s.rb == 0) { const float bs = wave_sum(sr * kq * rkc); if (lane == 0) BON[(size_t)tok * 12 + s.h] = bs; } } }
}
__device__ __forceinline__ void scan_flush(const KArgs& a, const SUnit& s, const float* outb, int ltid) {
    float* ORAW = (float*)(a.ws + WS_ORAW);
#pragma unroll
    for (int r = 0; r < 2; ++r) { const int t = (ltid >> 4) + 16 * r, i = ltid & 15;
        if (t < s.len) ORAW[(size_t)(s.tok0 + t) * 768 + s.h * 64 + s.rb * 16 + i] = outb[t * 16 + i]; }
}
__device__ __forceinline__ void phase4(const KArgs& a, unsigned char* lds, int tid, int wave, int lane) {
    const int blk = blockIdx.x; const int nunits = blk < 192 ? SEQ / TC : 96;
    float* bufs = (float*)lds; float* outs = (float*)(lds + SCAN_OUT_OFF);
    const int rs = lane >> 4, kg = lane & 15, rl = (wave & 3) * 4 + rs;
    f32x4 S = (f32x4){0.f, 0.f, 0.f, 0.f};
    if (wave >= 4) { const SUnit s0 = scan_unit(blk, 0); scan_prep(a, s0, bufs, wave - 4, lane, tid - 256); }
    __syncthreads();
#pragma unroll 1
    for (int u = 0; u < nunits; ++u) {
        if (wave < 4) {
            const SUnit s = scan_unit(blk, u);
            const float* VB = bufs + (u & 1) * SCAN_BUF_FLOATS; const float* VV = VB + TC * 320; const float* ST = VB + TC * 336; float* OB = outs + (u & 1) * (TC * 16);
            if (s.first) { if (s.prompt) S = (f32x4){0.f, 0.f, 0.f, 0.f}; else S = *(const f32x4*)(ST + rl * 64 + kg * 4); }
            f32x4 W = *(const f32x4*)(VB + kg * 4), NK = *(const f32x4*)(VB + 64 + kg * 4), B = *(const f32x4*)(VB + 128 + kg * 4), KQ = *(const f32x4*)(VB + 192 + kg * 4), R = *(const f32x4*)(VB + 256 + kg * 4);
            float vv = VV[rl];
#pragma unroll 2
            for (int t = 0; t < s.len; ++t) {
                const int tn = (t + 1 < s.len) ? t + 1 : t; const float* vn = VB + tn * 320 + kg * 4;
                const f32x4 nW = *(const f32x4*)(vn), nNK = *(const f32x4*)(vn + 64), nB = *(const f32x4*)(vn + 128), nKQ = *(const f32x4*)(vn + 192), nR = *(const f32x4*)(vn + 256);
                const float nvv = VV[tn * 16 + rl];
                float sa = (S[0] * NK[0] + S[1] * NK[1]) + (S[2] * NK[2] + S[3] * NK[3]);
                sa = rowsum16(sa);
                S = S * W + (B * sa + KQ * vv);
                float o = (S[0] * R[0] + S[1] * R[1]) + (S[2] * R[2] + S[3] * R[3]);
                o = rowsum16(o);
                if (kg == 0) OB[t * 16 + rl] = o;
                W = nW; NK = nNK; B = nB; KQ = nKQ; R = nR; vv = nvv;
            }
            if (s.last) { float* dst = a.out + (s.prompt ? O_WKV_P : O_WKV_S) + ((size_t)(s.b * 12 + s.h) * 64 + s.rb * 16 + rl) * 64 + kg * 4; *(f32x4*)dst = S; }
        } else {
            if (u > 0) { const SUnit sp = scan_unit(blk, u - 1); scan_flush(a, sp, outs + ((u - 1) & 1) * (TC * 16), tid - 256); }
            if (u + 1 < nunits) { const SUnit sn = scan_unit(blk, u + 1); scan_prep(a, sn, bufs + ((u + 1) & 1) * SCAN_BUF_FLOATS, wave - 4, lane, tid - 256); }
        }
        __syncthreads();
    }
    if (wave >= 4) { const SUnit sp = scan_unit(blk, nunits - 1); scan_flush(a, sp, outs + ((nunits - 1) & 1) * (TC * 16), tid - 256); }
}
__device__ __forceinline__ void phase5(const KArgs& a, int wave, int lane) {
    const unsigned char* ws = a.ws;
    const bf16_t* P = (const bf16_t*)(ws + WS_BIG); const float* ORAW = (const float*)(ws + WS_ORAW); const bf16_t* LRO = (const bf16_t*)(ws + WS_LRO); const float* BON = (const float*)(ws + WS_BONUS);
    bf16_t* ORW = (bf16_t*)(a.ws + WS_ORW);
    const int gw = blockIdx.x * 8 + wave, NGW = gridDim.x * 8;
    for (int task = gw; task < NTOK * 12; task += NGW) { const int tok = task / 12, h = task - tok * 12, ch = h * 64 + lane;
        const float o = ORAW[(size_t)tok * 768 + ch]; const float mean = wave_sum(o) * (1.f / 64.f); const float d = o - mean; const float var = wave_sum(d * d) * (1.f / 64.f);
        const float on = d * rsqrtf(var + 6.4e-4f) * a.in[21][ch] + a.in[22][ch];
        const float pv = bf2f(P[(size_t)tok * PIN + 1536 + ch]); float qv; bool is0; int bb = 0;
        if (tok < NPT) is0 = (tok & (SEQ - 1)) == 0; else { const int st = tok - NPT; is0 = (st & 7) == 0; bb = st >> 3; }
        if (is0) qv = (tok < NPT) ? 0.f : a.in[6][(size_t)bb * RWP + 1536 + ch]; else qv = bf2f(P[(size_t)(tok - 1) * PIN + 1536 + ch]);
        const float sv = pv + a.in[12][1536 + ch] * (qv - pv);
        const float res = (on + BON[(size_t)tok * 12 + h] * sv) * bf2f(LRO[(size_t)tok * 2304 + 1536 + ch]);
        ORW[(size_t)tok * 768 + ch] = f2bf(res); }
}
__device__ __forceinline__ void phase8(const KArgs& a, int wave, int lane) {
    unsigned char* ws = a.ws; const float* T1 = (const float*)(ws + WS_MRG); float* H = (float*)(ws + WS_H); bf16_t* HN = (bf16_t*)(ws + WS_XN);
    const int gw = blockIdx.x * 8 + wave, NGW = gridDim.x * 8;
    const f32x4* g1 = (const f32x4*)a.in[30] + lane; const f32x4* g2 = (const f32x4*)a.in[31] + lane;
    for (int m = gw; m < NTOK; m += NGW) {
        const f32x4* tr = (const f32x4*)(T1 + (size_t)m * DM) + lane; const f32x4* xr = (const f32x4*)xrow_ptr(a, m) + lane; f32x4* hr = (f32x4*)(H + (size_t)m * DM) + lane;
        f32x4 v[8]; float s = 0.f;
#pragma unroll
        for (int j = 0; j < 8; ++j) { v[j] = tr[64 * j]; s += (v[j][0] * v[j][0] + v[j][1] * v[j][1]) + (v[j][2] * v[j][2] + v[j][3] * v[j][3]); }
        const float rs = rsqrtf(wave_sum(s) * (1.f / DM) + NEPS); float s2 = 0.f;
#pragma unroll
        for (int j = 0; j < 8; ++j) { v[j] = xr[64 * j] + v[j] * rs * g1[64 * j]; hr[64 * j] = v[j]; s2 += (v[j][0] * v[j][0] + v[j][1] * v[j][1]) + (v[j][2] * v[j][2] + v[j][3] * v[j][3]); }
        const float rs2 = rsqrtf(wave_sum(s2) * (1.f / DM) + NEPS);
        u32x2* o8 = (u32x2*)(HN + (size_t)m * DM) + lane;
#pragma unroll
        for (int j = 0; j < 8; ++j) { const f32x4 gg = g2[64 * j]; u32x2 w; w.x = cvt_pk_bf16(v[j][0] * rs2 * gg[0], v[j][1] * rs2 * gg[1]); w.y = cvt_pk_bf16(v[j][2] * rs2 * gg[2], v[j][3] * rs2 * gg[3]); o8[64 * j] = w; }
    }
}
__device__ __forceinline__ float gelu_tanh(float x) { const float u = 0.7978845608028654f * (x + 0.044715f * x * x * x); const float e = __expf(2.f * u); const float th = 1.f - 2.f / (e + 1.f); return 0.5f * x * (1.f + th); }
__device__ __forceinline__ void unpack8(const u32x4 w, float (&f)[8]) { f[0] = bflo(w.x); f[1] = bfhi(w.x); f[2] = bflo(w.y); f[3] = bfhi(w.y); f[4] = bflo(w.z); f[5] = bfhi(w.z); f[6] = bflo(w.w); f[7] = bfhi(w.w); }
__device__ __forceinline__ void phase10(const KArgs& a, int tid) {
    unsigned char* ws = a.ws; const bf16_t* Z = (const bf16_t*)(ws + WS_BIG); bf16_t* ACT = (bf16_t*)(ws + WS_ACT); float* out = a.out;
    const float* cw = a.in[33]; const float* cb = a.in[34];
    for (int i = blockIdx.x * 512 + tid; i < NTOK * 704; i += gridDim.x * 512) {
        const int tok = i / 704, c = (i - tok * 704) * 8;
        int t, T, b; if (tok < NPT) { t = tok & (SEQ - 1); T = SEQ; b = tok >> 11; } else { const int st = tok - NPT; t = st & 7; T = 8; b = st >> 3; }
        float z0[8], z1[8], z2[8], zv[8];
        unpack8(*(const u32x4*)(Z + (size_t)tok * (2 * DFF) + c), z0);
        unpack8(*(const u32x4*)(Z + (size_t)tok * (2 * DFF) + DFF + c), zv);
        if (t >= 1) unpack8(*(const u32x4*)(Z + (size_t)(tok - 1) * (2 * DFF) + c), z1);
        else if (tok >= NPT) { const float* p = a.in[8] + ((size_t)b * 2 + 1) * DFF + c;
#pragma unroll
            for (int j = 0; j < 8; ++j) z1[j] = p[j]; }
        else {
#pragma unroll
            for (int j = 0; j < 8; ++j) z1[j] = 0.f; }
        if (t >= 2) unpack8(*(const u32x4*)(Z + (size_t)(tok - 2) * (2 * DFF) + c), z2);
        else if (tok >= NPT) { const float* p = a.in[8] + ((size_t)b * 2 + t) * DFF + c;
#pragma unroll
            for (int j = 0; j < 8; ++j) z2[j] = p[j]; }
        else {
#pragma unroll
            for (int j = 0; j < 8; ++j) z2[j] = 0.f; }
        float r[8];
#pragma unroll
        for (int j = 0; j < 8; ++j) { const float cv = cb[c + j] + cw[c + j] * z2[j] + cw[DFF + c + j] * z1[j] + cw[2 * DFF + c + j] * z0[j]; r[j] = gelu_tanh(cv) * zv[j]; }
        u32x4 w; w.x = cvt_pk_bf16(r[0], r[1]); w.y = cvt_pk_bf16(r[2], r[3]); w.z = cvt_pk_bf16(r[4], r[5]); w.w = cvt_pk_bf16(r[6], r[7]);
        *(u32x4*)(ACT + (size_t)tok * DFF + c) = w;
        if (t >= T - 2) { float* dst = out + (tok < NPT ? O_CONV_P : O_CONV_S) + ((size_t)b * 2 + (t - (T - 2))) * DFF + c;
            *(f32x4*)dst = (f32x4){z0[0], z0[1], z0[2], z0[3]}; *(f32x4*)(dst + 4) = (f32x4){z0[4], z0[5], z0[6], z0[7]}; }
    }
}
__device__ __forceinline__ void phase12(const KArgs& a, int wave, int lane) {
    const unsigned char* ws = a.ws; const float* F = (const float*)(ws + WS_MRG); const float* H = (const float*)(ws + WS_H);
    const int gw = blockIdx.x * 8 + wave, NGW = gridDim.x * 8;
    const f32x4* g = (const f32x4*)a.in[36] + lane;
    for (int m = gw; m < NTOK; m += NGW) {
        const f32x4* fr = (const f32x4*)(F + (size_t)m * DM) + lane; const f32x4* hr = (const f32x4*)(H + (size_t)m * DM) + lane; f32x4* yr = (f32x4*)(a.out + (size_t)m * DM) + lane;
        f32x4 v[8]; float s = 0.f;
#pragma unroll
        for (int j = 0; j < 8; ++j) { v[j] = fr[64 * j]; s += (v[j][0] * v[j][0] + v[j][1] * v[j][1]) + (v[j][2] * v[j][2] + v[j][3] * v[j][3]); }
        const float rs = rsqrtf(wave_sum(s) * (1.f / DM) + NEPS);
#pragma unroll
        for (int j = 0; j < 8; ++j) yr[64 * j] = hr[64 * j] + v[j] * rs * g[64 * j];
    }
}

__global__ void __launch_bounds__(512) fwd_megakernel(KArgs a) {
    extern __shared__ __attribute__((aligned(16))) unsigned char lds[];
    cg::grid_group grid = cg::this_grid();
    const int tid = threadIdx.x, lane = tid & 63, wave = __builtin_amdgcn_readfirstlane(tid >> 6);
    unsigned char* ws = a.ws;
    PG8_LAS unsigned char* ldsa = (PG8_LAS unsigned char*)lds;
    const int G = gridDim.x, c = blockIdx.x;
    bf16_t* P = (bf16_t*)(ws + WS_BIG);

#if !defined(ONLY) || ONLY == 0
    phase0(a, lds, tid, wave, lane);
#endif
    grid.sync();
#if !defined(ONLY) || ONLY == 1
    { pg8::Gemm g{(const bf16_t*)(ws + WS_XN), (const bf16_t*)(ws + WS_WT_IN), NTOK, PIN, DM}; pg8::StaticOrder S; S.init(NTOK, PIN, G, c);
      EpiB16 E{P, PIN, C_GATE / 256}; pg8::gemm_phase<EpiB16, pg8::StaticOrder>(ldsa, g, S, E, nullptr); }
    { pg8::Gemm g{(const bf16_t*)(ws + WS_MEMN), (const bf16_t*)(ws + WS_WT_MEMKV), 1024, 1024, DM}; pg8::StaticOrder S; S.init(1024, 1024, G, (c + G - 196) % G);
      EpiMemKV E{a.out + O_MEMK_P, a.out + O_MEMV_P, (bf16_t*)(ws + WS_MEMKV)}; pg8::gemm_phase<EpiMemKV, pg8::StaticOrder>(ldsa, g, S, E, nullptr); }
#endif
    grid.sync();
#if !defined(ONLY) || ONLY == 2
    phase2(a, lds, tid, wave, lane);
#endif
    grid.sync();
#if !defined(ONLY) || ONLY == 3
    { pg8::Gemm g{(const bf16_t*)(ws + WS_ALR), (const bf16_t*)(ws + WS_WT_LR), NTOK, 2304, 256}; pg8::StaticOrder S; S.init(NTOK, 2304, G, c);
      EpiB16 E{(bf16_t*)(ws + WS_LRO), 2304, 1 << 30}; pg8::gemm_phase<EpiB16, pg8::StaticOrder>(ldsa, g, S, E, nullptr); }
#endif
    grid.sync();
#if !defined(ONLY) || ONLY == 4
    phase4(a, lds, tid, wave, lane);
#endif
    grid.sync();
#if !defined(ONLY) || ONLY == 5
    phase5(a, wave, lane);
#endif
    grid.sync();
#if !defined(ONLY) || ONLY == 6
    { pg8::StaticOrder S; S.init(NTOK, DM, G, c);
      { pg8::Gemm g{(const bf16_t*)(ws + WS_ORW), (const bf16_t*)(ws + WS_WT_BR0), NTOK, DM, 768}; EpiBr<0> E{(float*)(ws + WS_MRG), nullptr, P + C_GATE}; pg8::gemm_phase<EpiBr<0>, pg8::StaticOrder>(ldsa, g, S, E, nullptr); }
      { pg8::Gemm g{(const bf16_t*)(ws + WS_OSW), (const bf16_t*)(ws + WS_WT_BR1), NTOK, DM, 768}; EpiBr<1> E{(float*)(ws + WS_MRG), nullptr, P + C_GATE + DM}; pg8::gemm_phase<EpiBr<1>, pg8::StaticOrder>(ldsa, g, S, E, nullptr); }
      { pg8::Gemm g{(const bf16_t*)(ws + WS_OMEM), (const bf16_t*)(ws + WS_WT_BR2), NTOK, DM, 512}; EpiBr<2> E{(float*)(ws + WS_MRG), (bf16_t*)(ws + WS_MERGEDB), P + C_GATE + 2 * DM}; pg8::gemm_phase<EpiBr<2>, pg8::StaticOrder>(ldsa, g, S, E, nullptr); } }
#endif
    grid.sync();
#if !defined(ONLY) || ONLY == 7
    { pg8::Gemm g{(const bf16_t*)(ws + WS_MERGEDB), (const bf16_t*)(ws + WS_WT_O), NTOK, DM, DM}; pg8::StaticOrder S; S.init(NTOK, DM, G, c);
      EpiF32 E{(float*)(ws + WS_MRG), DM}; pg8::gemm_phase<EpiF32, pg8::StaticOrder>(ldsa, g, S, E, nullptr); }
#endif
    grid.sync();
#if !defined(ONLY) || ONLY == 8
    phase8(a, wave, lane);
#endif
    grid.sync();
#if !defined(ONLY) || ONLY == 9
    { pg8::Gemm g{(const bf16_t*)(ws + WS_XN), (const bf16_t*)(ws + WS_WT_UP), NTOK, 2 * DFF, DM}; pg8::StaticOrder S; S.init(NTOK, 2 * DFF, G, c);
      EpiB16 E{P, 2 * DFF, 1 << 30}; pg8::gemm_phase<EpiB16, pg8::StaticOrder>(ldsa, g, S, E, nullptr); }
#endif
    grid.sync();
#if !defined(ONLY) || ONLY == 10
    phase10(a, tid);
#endif
    grid.sync();
#if !defined(ONLY) || ONLY == 11
    { pg8::Gemm g{(const bf16_t*)(ws + WS_ACT), (const bf16_t*)(ws + WS_WT_DN), NTOK, DM, DFF}; pg8::StaticOrder S; S.init(NTOK, DM, G, c);
      EpiF32 E{(float*)(ws + WS_MRG), DM}; pg8::gemm_phase<EpiF32, pg8::StaticOrder>(ldsa, g, S, E, nullptr); }
#endif
    grid.sync();
#if !defined(ONLY) || ONLY == 12
    phase12(a, wave, lane);
#endif

}

extern "C" void kernel_launch(void* const* d_in, const int* in_sizes, int n_in, void* d_out, int out_size, void* d_ws, size_t ws_size, hipStream_t stream) {
    static int grid_blocks = 0;
    if (grid_blocks == 0) {
        if (n_in != 37 || (size_t)out_size != O_END || ws_size < WS_END) { fprintf(stderr, "kernel_launch: unexpected problem (n_in %d out %d ws %zu need %zu)\n", n_in, out_size, ws_size, (size_t)WS_END); grid_blocks = -1; return; }
        if (hipFuncSetAttribute((const void*)fwd_megakernel, hipFuncAttributeMaxDynamicSharedMemorySize, LDS_BYTES) != hipSuccess) { fprintf(stderr, "kernel_launch: hipFuncSetAttribute failed\n"); grid_blocks = -1; return; }
        int dev = 0, cus = 0, per_cu = 0;
        hipGetDevice(&dev); hipDeviceGetAttribute(&cus, hipDeviceAttributeMultiprocessorCount, dev);
        hipOccupancyMaxActiveBlocksPerMultiprocessor(&per_cu, (const void*)fwd_megakernel, 512, LDS_BYTES);
        (void)hipGetLastError();
        if (cus < 256 || per_cu < 1) fprintf(stderr, "kernel_launch: note: cus %d per_cu %d\n", cus, per_cu);
        grid_blocks = 256;
    }
    if (grid_blocks < 0) return;
    KArgs a{};
    for (int i = 0; i < 37; ++i) a.in[i] = (const float*)d_in[i];
    a.out = (float*)d_out; a.ws = (unsigned char*)d_ws;
    void* args[] = {&a};
    hipError_t e = hipLaunchCooperativeKernel((const void*)fwd_megakernel, dim3(grid_blocks), dim3(512), args, LDS_BYTES, stream);
    if (e != hipSuccess) fprintf(stderr, "cooperative launch failed: %s (grid %d)\n", hipGetErrorString(e), grid_blocks);
}
```

```cpp
#include <hip/hip_runtime.h>
#include <hip/hip_cooperative_groups.h>
#include <cstdio>
__device__ __forceinline__ int opaque_tid() { int t = threadIdx.x; asm volatile("" : "+v"(t)); return t; }
namespace pg8 {
#define PG8_LAS __attribute__((address_space(3)))
typedef unsigned short bf16_t;
typedef short bf16x8 __attribute__((ext_vector_type(8)));
typedef float f32x4 __attribute__((ext_vector_type(4)));
typedef unsigned u32x4 __attribute__((ext_vector_type(4)));
constexpr int BM = 256, BK = 64, HALF = 128, HTB = HALF * BK * 2  , STAGE_BYTES = 8 * HTB, NXCD = 8, WGM = 8;

__host__ __device__ __forceinline__ int lds_byte(int r, int c) { const int st = (r >> 4) * 2 + (c >> 5), rr = r & 15, cc = c & 31, ob = rr * 64 + cc * 2; return st * 1024 + (ob ^ (((ob >> 9) & 1) << 5)); }
__host__ __device__ __forceinline__ void stage_rc(int b, int& R, int& C) { const int st = b / 1024, sb = b % 1024, swz = sb ^ (((sb >> 9) & 1) << 5); R = (st >> 1) * 16 + swz / 64; C = (st & 1) * 32 + (swz % 64) / 2; }
__host__ __device__ __forceinline__ int perm32(int rho) { const int n = rho >> 4, i = rho & 15; return 8 * (i >> 2) + 4 * n + (i & 3); }

struct Unit { int pm, pn, k0, nt, ks; };
struct Gemm { const bf16_t* A; const bf16_t* Bt; int M, N, K; };

struct StaticOrder {
    int nM, nN, nwg, G, c;
    __host__ __device__ void init(int M, int N, int G_, int c_) { nM = M / BM; nN = N / BM; nwg = nM * nN; G = G_; c = c_; }
    __host__ __device__ bool next(int i, Unit& u) const {
        const long L = (long)i * G + c; if (L >= nwg) return false;
        int wgid = (int)L; { const int q = nwg / NXCD, r = nwg % NXCD, xcd = wgid % NXCD, off = wgid / NXCD; wgid = (xcd < r ? xcd * (q + 1) : r * (q + 1) + (xcd - r) * q) + off; }
        const int nig = WGM * nN, gid = wgid / nig, fm = gid * WGM, gsz = (nM - fm) < WGM ? (nM - fm) : WGM;
        u.pm = fm + ((wgid % nig) % gsz); u.pn = (wgid % nig) / gsz; u.k0 = 0; u.nt = 0; u.ks = -1; return true;
    }
    __device__ __forceinline__ void a_ready(const Unit&) const {}
    __device__ __forceinline__ void done(const Unit&) const {}
};
__device__ __forceinline__ unsigned cvt_pk_bf16(float lo, float hi) { unsigned r; asm volatile("v_cvt_pk_bf16_f32 %0, %1, %2" : "=v"(r) : "v"(lo), "v"(hi)); return r; }
typedef float f32x2 __attribute__((ext_vector_type(2)));
template <class Epi, class Sched, bool STAMP = false>
__device__ __forceinline__ void gemm_phase(PG8_LAS unsigned char* lds, const Gemm g, const Sched& S, const Epi& E, unsigned long long* stamps) {
    const int tid = opaque_tid(), wid = __builtin_amdgcn_readfirstlane(tid >> 6), lane = tid & 63, wr = wid >> 2, wc = wid & 3, fr = lane & 15, fq = lane >> 4;
    const int K = g.K, ntf = K / BK;
    int ts_lo = 0, ts_hi = 0, nts = 0; const unsigned long long rt_entry = STAMP ? (unsigned long long)wall_clock64() : 0ull;
#define PG8_STAMP() do { if (STAMP && wid == 0 && nts < 64) { const unsigned long long _c = (unsigned long long)clock64(); \
        ts_lo = (lane == nts) ? (int)(unsigned)_c : ts_lo; ts_hi = (lane == nts) ? (int)(unsigned)(_c >> 32) : ts_hi; ++nts; } } while (0)
    PG8_STAMP();
    unsigned voffA[2], voffB[2];
#pragma unroll
    for (int i = 0; i < 2; ++i) { int R, C; stage_rc(tid * 16 + i * 8192, R, C); const int Rb = Epi::PERM ? ((R & ~31) + perm32(R & 31)) : R;
        voffA[i] = (unsigned)(R * K + C) * 2u; voffB[i] = (unsigned)(Rb * K + C) * 2u; }
    const size_t kstep = (size_t)(BK * 2);
    const size_t hstep = (size_t)HALF * K * 2;
    const size_t tstep = 2 * hstep;
    const unsigned ldsw = (unsigned)wid * 1024u;
    const int aoff = lds_byte(wr * 64 + fr, fq * 8), boff = lds_byte(wc * 32 + fr, fq * 8);
#define PG8_SA(b, h) (((b) * 2 + (h)) * HTB)
#define PG8_SB(b, h) ((4 + (b) * 2 + (h)) * HTB)
#define PG8_STAGE(bufoff, gbase, voff) do { _Pragma("unroll") for (int _i = 0; _i < 2; ++_i) \
        __builtin_amdgcn_global_load_lds((const unsigned*)((const char*)(gbase) + (voff)[_i]), (PG8_LAS unsigned*)(lds + (bufoff) + ldsw + _i * 8192), 16, 0, 0); } while (0)
#define PG8_LDA(dst, b, h) do { _Pragma("unroll") for (int m = 0; m < 4; ++m) _Pragma("unroll") for (int k = 0; k < 2; ++k) dst[m][k] = *(const PG8_LAS bf16x8*)(lds + PG8_SA(b, h) + aoff + m * 2048 + k * 1024); } while (0)
#define PG8_LDB(dst, b, h) do { _Pragma("unroll") for (int n = 0; n < 2; ++n) _Pragma("unroll") for (int k = 0; k < 2; ++k) dst[n][k] = *(const PG8_LAS bf16x8*)(lds + PG8_SB(b, h) + boff + n * 2048 + k * 1024); } while (0)
#define PG8_MMA(ai, bj, At, Bt) do { __builtin_amdgcn_s_setprio(1); _Pragma("unroll") for (int m = 0; m < 4; ++m) _Pragma("unroll") for (int n = 0; n < 2; ++n) _Pragma("unroll") for (int k = 0; k < 2; ++k) \
        acc[ai][bj][m][n] = __builtin_amdgcn_mfma_f32_16x16x32_bf16(Bt[n][k], At[m][k], acc[ai][bj][m][n], 0, 0, 0); __builtin_amdgcn_s_setprio(0); } while (0)
#define PG8_WAIT_V(n) asm volatile("s_waitcnt vmcnt(" #n ")" ::: "memory")
#define PG8_WAIT_L(n) asm volatile("s_waitcnt lgkmcnt(" #n ")" ::: "memory")
#define PG8_BAR __builtin_amdgcn_s_barrier()
#define PG8_SCHED __builtin_amdgcn_sched_barrier(0)
    Unit cur, nxt; int ui = 0;
    if (!S.next(0, cur)) return;
    if (cur.nt == 0) cur.nt = ntf;
    f32x4 acc[2][2][4][2];
#pragma unroll
    for (int a = 0; a < 2; ++a)
#pragma unroll
        for (int b = 0; b < 2; ++b)
#pragma unroll
            for (int m = 0; m < 4; ++m)
#pragma unroll
                for (int n = 0; n < 2; ++n) acc[a][b][m][n] = (f32x4){0.f, 0.f, 0.f, 0.f};
    bf16x8 At[4][2], B0[2][2], B1[2][2];
    const char* cA = (const char*)g.A + (size_t)cur.pm * tstep + (size_t)cur.k0 * 2; const char* cB = (const char*)g.Bt + (size_t)cur.pn * tstep + (size_t)cur.k0 * 2;
    S.a_ready(cur);
    PG8_STAGE(PG8_SB(0, 0), cB, voffB); PG8_STAGE(PG8_SA(0, 0), cA, voffA); PG8_STAGE(PG8_SB(0, 1), cB + hstep, voffB); PG8_STAGE(PG8_SA(0, 1), cA + hstep, voffA);
    if (wr == 1) PG8_BAR;
    PG8_WAIT_V(4); PG8_BAR;
    PG8_STAGE(PG8_SB(1, 0), cB + kstep, voffB); PG8_STAGE(PG8_SA(1, 0), cA + kstep, voffA); PG8_STAGE(PG8_SB(1, 1), cB + hstep + kstep, voffB);
    PG8_WAIT_V(6); PG8_BAR;
    PG8_STAMP();
    for (;;) {
        const bool has_next = S.next(ui + 1, nxt);
        if (has_next && nxt.nt == 0) nxt.nt = ntf;
        const int nt = cur.nt;
        const char* nA = has_next ? (const char*)g.A + (size_t)nxt.pm * tstep + (size_t)nxt.k0 * 2 : cA; const char* nB = has_next ? (const char*)g.Bt + (size_t)nxt.pn * tstep + (size_t)nxt.k0 * 2 : cB;
        for (int t = 0; t < nt; t += 2) {
            const bool last = (t == nt - 2);
            const char* a1 = cA + (size_t)(t + 1) * kstep;
            const char* a2 = last ? nA : cA + (size_t)(t + 2) * kstep; const char* b2 = last ? nB : cB + (size_t)(t + 2) * kstep;
            const char* a3 = a2 + kstep; const char* b3 = b2 + kstep;
            if (last && has_next) S.a_ready(nxt);
            PG8_LDB(B0, 0, 0); PG8_SCHED; PG8_LDA(At, 0, 0); PG8_STAGE(PG8_SA(1, 1), a1 + hstep, voffA);
            PG8_WAIT_L(8); PG8_BAR; PG8_WAIT_L(0); PG8_MMA(0, 0, At, B0); PG8_BAR; PG8_SCHED;
            PG8_LDB(B1, 0, 1); PG8_STAGE(PG8_SB(0, 0), b2, voffB);
            PG8_BAR; PG8_WAIT_L(0); PG8_MMA(0, 1, At, B1); PG8_BAR;
            PG8_LDA(At, 0, 1); PG8_STAGE(PG8_SA(0, 0), a2, voffA);
            PG8_BAR; PG8_WAIT_L(0); PG8_MMA(1, 0, At, B0); PG8_BAR; PG8_SCHED;
            PG8_STAGE(PG8_SB(0, 1), b2 + hstep, voffB);
            PG8_WAIT_V(6); PG8_BAR; PG8_MMA(1, 1, At, B1); PG8_BAR;
            PG8_LDB(B0, 1, 0); PG8_SCHED; PG8_LDA(At, 1, 0); PG8_STAGE(PG8_SA(0, 1), a2 + hstep, voffA);
            PG8_WAIT_L(8); PG8_BAR; PG8_WAIT_L(0); PG8_MMA(0, 0, At, B0); PG8_BAR; PG8_SCHED;
            PG8_LDB(B1, 1, 1); PG8_STAGE(PG8_SB(1, 0), b3, voffB);
            PG8_BAR; PG8_WAIT_L(0); PG8_MMA(0, 1, At, B1); PG8_BAR;
            PG8_LDA(At, 1, 1); PG8_STAGE(PG8_SA(1, 0), a3, voffA);
            PG8_BAR; PG8_WAIT_L(0); PG8_MMA(1, 0, At, B0); PG8_BAR; PG8_SCHED;
            PG8_STAGE(PG8_SB(1, 1), b3 + hstep, voffB);
            PG8_WAIT_V(6); PG8_BAR; PG8_MMA(1, 1, At, B1); PG8_BAR;
        }
        PG8_STAMP();
        if constexpr (!Epi::AFTER_DRAIN) { E(acc, cur, wr, wc, fr, fq); S.done(cur); }
        PG8_STAMP();
        if (!has_next) break;
#pragma unroll
        for (int a = 0; a < 2; ++a)
#pragma unroll
            for (int b = 0; b < 2; ++b)
#pragma unroll
                for (int m = 0; m < 4; ++m)
#pragma unroll
                    for (int n = 0; n < 2; ++n) acc[a][b][m][n] = (f32x4){0.f, 0.f, 0.f, 0.f};
        cur = nxt; cA = nA; cB = nB; ++ui;
    }
    PG8_WAIT_V(0);
    if (wr == 0) PG8_BAR;
    PG8_BAR;
    if constexpr (Epi::AFTER_DRAIN) { E.fused(acc, cur, wr, wc, fr, fq, lds, wid, lane); S.done(cur); }
    PG8_STAMP();
    if (STAMP && wid == 0) { stamps[lane] = lane < nts ? (((unsigned long long)(unsigned)ts_hi << 32) | (unsigned)ts_lo) : 0ull;
        if (lane == 62) stamps[62] = rt_entry; if (lane == 63) stamps[63] = (unsigned long long)wall_clock64(); }
#undef PG8_STAMP
#undef PG8_SA
#undef PG8_SB
#undef PG8_STAGE
#undef PG8_LDA
#undef PG8_LDB
#undef PG8_MMA
#undef PG8_WAIT_V
#undef PG8_WAIT_L
#undef PG8_BAR
#undef PG8_SCHED
}
}

namespace cg = cooperative_groups;
using pg8::bf16_t; using pg8::bf16x8; using pg8::f32x4; using pg8::u32x4; using pg8::cvt_pk_bf16;
typedef unsigned u32x2 __attribute__((ext_vector_type(2)));

constexpr int DM = 2048, NTOK = 9216, NPT = 8192, SEQ = 2048, PIN = 10496, RWW = 768, RWP = 2560, DFF = 5632;
constexpr int C_QSW = 2560, C_KSW = 3328, C_VSW = 3584, C_QMEM = 3840, C_GATE = 4352;
constexpr int LDS_BYTES = 147456;
constexpr float NEPS = 1e-6f;

constexpr size_t WS_WT_IN = 0;
constexpr size_t WS_WT_MEMKV = WS_WT_IN + (size_t)PIN * DM * 2;
constexpr size_t WS_WT_LR = WS_WT_MEMKV + (size_t)1024 * DM * 2;
constexpr size_t WS_WT_BR0 = WS_WT_LR + (size_t)2304 * 256 * 2;
constexpr size_t WS_WT_BR1 = WS_WT_BR0 + (size_t)DM * 768 * 2;
constexpr size_t WS_WT_BR2 = WS_WT_BR1 + (size_t)DM * 768 * 2;
constexpr size_t WS_WT_O = WS_WT_BR2 + (size_t)DM * 512 * 2;
constexpr size_t WS_XN = WS_WT_O + (size_t)DM * DM * 2;
constexpr size_t WS_MEMN = WS_XN + (size_t)NTOK * DM * 2;
constexpr size_t WS_MEMKV = WS_MEMN + (size_t)1024 * DM * 2;
constexpr size_t WS_ALR = WS_MEMKV + (size_t)1024 * 1024 * 2;
constexpr size_t WS_WT_UP = WS_ALR + (size_t)NTOK * 256 * 2;
constexpr size_t WS_WT_DN = WS_WT_UP + (size_t)2 * DFF * DM * 2;
constexpr size_t WS_BIG = WS_WT_DN + (size_t)DM * DFF * 2;
constexpr size_t WS_H = WS_BIG + (size_t)NTOK * 2 * DFF * 2;
constexpr size_t WS_MRG = WS_H + (size_t)NTOK * DM * 4;
constexpr size_t WS_END = WS_MRG + (size_t)NTOK * DM * 4;
constexpr size_t WS_BAR = WS_END;
constexpr size_t WS_TOTAL = WS_BAR + 16384;
constexpr size_t WS_SLAB = WS_BIG;
constexpr size_t WS_SLU = WS_MRG;
constexpr size_t WS_SLB = WS_H;
constexpr size_t WS_ACT = 0;
constexpr size_t WS_ORW = WS_WT_IN;
constexpr size_t WS_OSW = WS_ORW + (size_t)NTOK * 768 * 2;
constexpr size_t WS_OMEM = WS_OSW + (size_t)NTOK * 768 * 2;
constexpr size_t WS_MERGEDB = WS_XN;
constexpr size_t WS_LRO = WS_H;
constexpr size_t WS_ORAW = WS_MRG;
constexpr size_t WS_BONUS = WS_ORAW + (size_t)NTOK * 768 * 4;
constexpr size_t PREP_E = (size_t)NPT * 12 * 64;
constexpr size_t WS_PB = WS_XN;
constexpr size_t WS_PKQ = WS_PB + PREP_E * 2;
constexpr size_t WS_PR = WS_PKQ + PREP_E * 2;
constexpr size_t WS_PW = WS_LRO + (size_t)NTOK * 2304 * 2;
constexpr size_t WS_PNK = WS_BONUS + (size_t)NTOK * 12 * 4;
constexpr size_t WS_PV = WS_PNK + PREP_E * 4;
static_assert(WS_PR + PREP_E * 2 <= WS_WT_UP, "prep alias 1");
static_assert(WS_PW + PREP_E * 4 <= WS_MRG, "prep alias 2");
static_assert(WS_PV + PREP_E * 2 <= WS_END, "prep alias 3");
static_assert(WS_ACT + (size_t)NTOK * DFF * 2 <= WS_WT_UP, "ACT alias");
static_assert(WS_OMEM + (size_t)NTOK * 512 * 2 <= WS_WT_MEMKV, "O alias");
static_assert(WS_BONUS + (size_t)NTOK * 12 * 4 <= WS_END, "bonus alias");

constexpr size_t O_Y = 0;
constexpr size_t O_SWAK_P = (size_t)NTOK * DM;
constexpr size_t O_SWAV_P = O_SWAK_P + 131072;
constexpr size_t O_MEMK_P = O_SWAV_P + 131072;
constexpr size_t O_MEMV_P = O_MEMK_P + 524288;
constexpr size_t O_SHIFT_P = O_MEMV_P + 524288;
constexpr size_t O_WKV_P = O_SHIFT_P + 10240;
constexpr size_t O_CONV_P = O_WKV_P + 196608;
constexpr size_t O_SWAK_S = O_CONV_P + 45056;
constexpr size_t O_SWAV_S = O_SWAK_S + 4194304;
constexpr size_t O_SHIFT_S = O_SWAV_S + 4194304;
constexpr size_t O_WKV_S = O_SHIFT_S + 327680;
constexpr size_t O_CONV_S = O_WKV_S + 6291456;
constexpr size_t O_END = O_CONV_S + 1441792;

struct KArgs { const float* in[37]; float* out; unsigned char* ws; };
extern __shared__ __attribute__((aligned(16))) unsigned char g_lds[];
constexpr int PTAB_OFF = LDS_BYTES - 16 - 40 * 8;
__device__ __forceinline__ const float* INP(int k) {
    const unsigned long long v = *(const unsigned long long*)(g_lds + PTAB_OFF + 8 * k);
    const unsigned lo = (unsigned)__builtin_amdgcn_readfirstlane((int)(unsigned)v), hi = (unsigned)__builtin_amdgcn_readfirstlane((int)(unsigned)(v >> 32));
    return (const float*)(((unsigned long long)hi << 32) | lo);
}

__device__ __forceinline__ float bflo(unsigned u) { return __uint_as_float(u << 16); }
__device__ __forceinline__ float bfhi(unsigned u) { return __uint_as_float(u & 0xffff0000u); }
__device__ __forceinline__ float bf2f(bf16_t b) { return __uint_as_float(((unsigned)b) << 16); }
__device__ __forceinline__ bf16_t f2bf(float f) { return (bf16_t)(cvt_pk_bf16(f, 0.f) & 0xffffu); }
__device__ __forceinline__ float sigmoidf_(float v) { return __builtin_amdgcn_rcpf(1.f + __expf(-v)); }
#define DPP_ADD(v, ctrl) v += __int_as_float(__builtin_amdgcn_update_dpp(0, __float_as_int(v), ctrl, 0xF, 0xF, false))
__device__ __forceinline__ float rowsum16(float v) { DPP_ADD(v, 0xB1); DPP_ADD(v, 0x4E); DPP_ADD(v, 0x141); DPP_ADD(v, 0x140); return v; }
__device__ __forceinline__ float wave_sum(float v) { v = rowsum16(v); const int iv = __float_as_int(v);
    const float s0 = __int_as_float(__builtin_amdgcn_readlane(iv, 0)), s1 = __int_as_float(__builtin_amdgcn_readlane(iv, 16)), s2 = __int_as_float(__builtin_amdgcn_readlane(iv, 32)), s3 = __int_as_float(__builtin_amdgcn_readlane(iv, 48));
    return (s0 + s1) + (s2 + s3); }
__device__ __forceinline__ void lds_fence() { asm volatile("s_waitcnt lgkmcnt(0)" ::: "memory"); }

struct EpiF32 {
    static constexpr bool PERM = false, AFTER_DRAIN = false;
    float* C; int ldc;
    __device__ __forceinline__ void operator()(const f32x4 (&acc)[2][2][4][2], const pg8::Unit& u, int wr, int wc, int fr, int fq) const {
        const int row0 = u.pm * 256 + wr * 64 + fr, col0 = u.pn * 256 + wc * 32 + 4 * fq;
#pragma unroll
        for (int ai = 0; ai < 2; ++ai)
#pragma unroll
            for (int m = 0; m < 4; ++m) { float* rowp = C + (size_t)(row0 + ai * 128 + m * 16) * ldc + col0;
#pragma unroll
                for (int bj = 0; bj < 2; ++bj)
#pragma unroll
                    for (int n = 0; n < 2; ++n) *(f32x4*)(rowp + bj * 128 + n * 16) = acc[ai][bj][m][n]; }
    }
};
struct EpiB16 {
    static constexpr bool PERM = true, AFTER_DRAIN = false;
    bf16_t* O; int ldc; int sig_pn;
    __device__ __forceinline__ void operator()(const f32x4 (&acc)[2][2][4][2], const pg8::Unit& u, int wr, int wc, int fr, int fq) const {
        const int row0 = u.pm * 256 + wr * 64 + fr, col0 = u.pn * 256 + wc * 32 + 8 * fq;
        const bool sig = u.pn >= sig_pn;
#pragma unroll
        for (int ai = 0; ai < 2; ++ai)
#pragma unroll
            for (int m = 0; m < 4; ++m) { bf16_t* rowp = O + (size_t)(row0 + ai * 128 + m * 16) * ldc + col0;
#pragma unroll
                for (int bj = 0; bj < 2; ++bj) { f32x4 v0 = acc[ai][bj][m][0], v1 = acc[ai][bj][m][1];
                    if (sig) {
#pragma unroll
                        for (int j = 0; j < 4; ++j) { v0[j] = sigmoidf_(v0[j]); v1[j] = sigmoidf_(v1[j]); } }
                    u32x4 w; w.x = cvt_pk_bf16(v0[0], v0[1]); w.y = cvt_pk_bf16(v0[2], v0[3]); w.z = cvt_pk_bf16(v1[0], v1[1]); w.w = cvt_pk_bf16(v1[2], v1[3]);
                    if (sig) __builtin_nontemporal_store(w, (u32x4*)(rowp + bj * 128)); else *(u32x4*)(rowp + bj * 128) = w; } }
    }
};
struct EpiMemKV {
    static constexpr bool PERM = true, AFTER_DRAIN = false;
    float* OK; float* OV; bf16_t* B;
    __device__ __forceinline__ void operator()(const f32x4 (&acc)[2][2][4][2], const pg8::Unit& u, int wr, int wc, int fr, int fq) const {
        const int row0 = u.pm * 256 + wr * 64 + fr, col0 = u.pn * 256 + wc * 32 + 8 * fq;
        float* F = (u.pn >= 2) ? OV : OK; const int fcol0 = col0 & 511;
#pragma unroll
        for (int ai = 0; ai < 2; ++ai)
#pragma unroll
            for (int m = 0; m < 4; ++m) { const int row = row0 + ai * 128 + m * 16;
#pragma unroll
                for (int bj = 0; bj < 2; ++bj) { const f32x4 v0 = acc[ai][bj][m][0], v1 = acc[ai][bj][m][1];
                    *(f32x4*)(F + (size_t)row * 512 + fcol0 + bj * 128) = v0; *(f32x4*)(F + (size_t)row * 512 + fcol0 + bj * 128 + 4) = v1;
                    u32x4 w; w.x = cvt_pk_bf16(v0[0], v0[1]); w.y = cvt_pk_bf16(v0[2], v0[3]); w.z = cvt_pk_bf16(v1[0], v1[1]); w.w = cvt_pk_bf16(v1[2], v1[3]);
                    *(u32x4*)(B + (size_t)row * 1024 + col0 + bj * 128) = w; } }
    }
};
template <int MODE> struct EpiBr {
    static constexpr bool PERM = false, AFTER_DRAIN = false;
    float* MG; bf16_t* MB; const bf16_t* GATE;
    __device__ __forceinline__ void operator()(const f32x4 (&acc)[2][2][4][2], const pg8::Unit& u, int wr, int wc, int fr, int fq) const {
        const int row0 = u.pm * 256 + wr * 64 + fr, col0 = u.pn * 256 + wc * 32 + 4 * fq;
#pragma unroll
        for (int ai = 0; ai < 2; ++ai)
#pragma unroll
            for (int m = 0; m < 4; ++m) { const size_t row = (size_t)(row0 + ai * 128 + m * 16);
#pragma unroll
                for (int bj = 0; bj < 2; ++bj)
#pragma unroll
                    for (int n = 0; n < 2; ++n) { const int c = col0 + bj * 128 + n * 16;
                        const u32x2 gw = *(const u32x2*)(GATE + row * PIN + c);
                        f32x4 v = acc[ai][bj][m][n]; v[0] *= bflo(gw.x); v[1] *= bfhi(gw.x); v[2] *= bflo(gw.y); v[3] *= bfhi(gw.y);
                        if (MODE >= 1) v += *(const f32x4*)(MG + row * DM + c);
                        if (MODE <= 1) *(f32x4*)(MG + row * DM + c) = v;
                        else { u32x2 w; w.x = cvt_pk_bf16(v[0], v[1]); w.y = cvt_pk_bf16(v[2], v[3]); *(u32x2*)(MB + row * DM + c) = w; } } }
    }
};


#define XB_TMO      128
#define XB_XCNT(j)  (256  + 64 * (j))
#define XB_XSUB(j)  (1280 + 64 * (j))
#define XB_XGEN(j)  (2304 + 64 * (j))
#define XB_TOP      3328
#define XB_TOPGEN   3392
#define XCD_BAR_WORDS 3456
#define XB_SPIN_CAP (1u << 18)
__device__ __forceinline__ unsigned xb_ld(unsigned* p)              { return __hip_atomic_load(p, __ATOMIC_RELAXED, __HIP_MEMORY_SCOPE_AGENT); }
__device__ __forceinline__ unsigned xb_add(unsigned* p, unsigned v) { return __hip_atomic_fetch_add(p, v, __ATOMIC_RELAXED, __HIP_MEMORY_SCOPE_AGENT); }
__device__ __forceinline__ unsigned xb_xcc_id() { return (unsigned)__builtin_amdgcn_s_getreg((3 << 11) | 20) & 0xFu; }
#define XB_SPIN(cond, bar) do { unsigned _sp = 0; while (cond) { __builtin_amdgcn_s_sleep(1); \
    if ((++_sp & 255u) == 0u) { if (xb_ld(&(bar)[XB_TMO])) break; if (_sp > XB_SPIN_CAP) { atomicAdd(&(bar)[XB_TMO], 1u); break; } } } } while (0)
struct XcdBarrier { unsigned* bar; unsigned x; volatile PG8_LAS unsigned* st; };
__device__ __forceinline__ XcdBarrier xcd_barrier_post(unsigned* bar, volatile PG8_LAS unsigned* st) {
    XcdBarrier b; b.bar = bar; b.x = xb_xcc_id(); b.st = st;
    if (threadIdx.x == 0) (void)xb_add(&bar[XB_XCNT(b.x)], 1u);
    return b;
}
__device__ __forceinline__ void xcd_barrier_complete(unsigned* bar, unsigned x, unsigned& nloc, unsigned& nx) {
    const unsigned G = gridDim.x * gridDim.y * gridDim.z;
    unsigned sum, cnt, mine, sp = 0u;
    for (;;) {
        sum = 0u; cnt = 0u; mine = 0u;
#pragma unroll
        for (unsigned j = 0; j < 16; ++j) { const unsigned c = xb_ld(&bar[XB_XCNT(j)]); sum += c; cnt += (c > 0u) ? 1u : 0u; mine = (j == x) ? c : mine; }
        if (sum == G) break;
        __builtin_amdgcn_s_sleep(1);
        if ((++sp & 255u) == 0u) { if (xb_ld(&bar[XB_TMO])) break; if (sp > XB_SPIN_CAP) { atomicAdd(&bar[XB_TMO], 1u); break; } }
    }
    nloc = mine > 0u ? mine : 1u; nx = cnt > 0u ? cnt : 1u;
}
__device__ __forceinline__ void xcd_barrier(const XcdBarrier& b) {
    asm volatile("s_waitcnt vmcnt(0)" ::: "memory");
    __syncthreads();
    if (threadIdx.x == 0) {
        unsigned* bar = b.bar;
        __builtin_amdgcn_s_waitcnt(0);
        unsigned nloc = b.st[0], nx = b.st[1];
        if (nloc == 0u) { xcd_barrier_complete(bar, b.x, nloc, nx); b.st[0] = nloc; b.st[1] = nx; }
        const unsigned old = xb_add(&bar[XB_XSUB(b.x)], 1u);
        const unsigned gen = old / nloc;
        if (old + 1u == (gen + 1u) * nloc) {
            __builtin_amdgcn_fence(__ATOMIC_RELEASE, "agent");
            asm volatile("s_waitcnt vmcnt(0)" ::: "memory");
            const unsigned og = xb_add(&bar[XB_TOP], 1u);
            const unsigned tg = og / nx;
            if (og + 1u == (tg + 1u) * nx) xb_add(&bar[XB_TOPGEN], 1u);
            else XB_SPIN(xb_ld(&bar[XB_TOPGEN]) == tg, bar);
            __builtin_amdgcn_fence(__ATOMIC_ACQUIRE, "agent");
            xb_add(&bar[XB_XGEN(b.x)], 1u);
            asm volatile("s_waitcnt vmcnt(0)" ::: "memory");
        } else {
            XB_SPIN(xb_ld(&bar[XB_XGEN(b.x)]) == gen, bar);
            __builtin_amdgcn_fence(__ATOMIC_ACQUIRE, "agent");
            asm volatile("s_waitcnt vmcnt(0)" ::: "memory");
        }
    }
    __syncthreads();
}
struct RemOrder {
    pg8::StaticOrder so; int c, kblocks;
    __device__ void init(int G, int c_, int K) { so.init(8192, 2048, G, c_); c = c_; kblocks = K / 128; }
    __device__ bool next(int i, pg8::Unit& u) const {
        if (i == 0) return so.next(0, u);
        if (i == 1) { const int ks = c & 7, base = kblocks >> 3, rem = kblocks & 7; u.pm = 32 + (c >> 6); u.pn = (c >> 3) & 7;
            const int start = ks * base + (ks < rem ? ks : rem), cnt = base + (ks < rem ? 1 : 0); u.k0 = start * 128; u.nt = cnt * 2; u.ks = ks; return true; }
        return false;
    }
    __device__ __forceinline__ void a_ready(const pg8::Unit&) const {}
    __device__ __forceinline__ void done(const pg8::Unit&) const {}
};
struct EpiB16S {
    static constexpr bool PERM = true, AFTER_DRAIN = false;
    bf16_t* C; float* SLAB;
    __device__ __forceinline__ void operator()(const f32x4 (&acc)[2][2][4][2], const pg8::Unit& u, int wr, int wc, int fr, int fq) const {
        const int row0 = u.pm * 256 + wr * 64 + fr, col0 = u.pn * 256 + wc * 32 + 8 * fq;
        if (u.ks < 0) {
#pragma unroll
            for (int ai = 0; ai < 2; ++ai)
#pragma unroll
                for (int m = 0; m < 4; ++m) { bf16_t* rowp = C + (size_t)(row0 + ai * 128 + m * 16) * DM + col0;
#pragma unroll
                    for (int bj = 0; bj < 2; ++bj) { const f32x4 v0 = acc[ai][bj][m][0], v1 = acc[ai][bj][m][1];
                        u32x4 w; w.x = cvt_pk_bf16(v0[0], v0[1]); w.y = cvt_pk_bf16(v0[2], v0[3]); w.z = cvt_pk_bf16(v1[0], v1[1]); w.w = cvt_pk_bf16(v1[2], v1[3]);
                        *(u32x4*)(rowp + bj * 128) = w; } }
        } else {
            float* base = SLAB + ((size_t)u.ks * 1024 + (row0 - 8192)) * DM + col0;
#pragma unroll
            for (int ai = 0; ai < 2; ++ai)
#pragma unroll
                for (int m = 0; m < 4; ++m) { float* rowp = base + (size_t)(ai * 128 + m * 16) * DM;
#pragma unroll
                    for (int bj = 0; bj < 2; ++bj) { *(f32x4*)(rowp + bj * 128) = acc[ai][bj][m][0]; *(f32x4*)(rowp + bj * 128 + 4) = acc[ai][bj][m][1]; } }
        }
    }
};
struct UpOrder {
    pg8::StaticOrder so; int c;
    __device__ void init(int G, int c_) { so.init(8704, 2 * DFF, G, c_); c = c_; }
    __device__ bool next(int i, pg8::Unit& u) const {
        const int L = i * 256 + c;
        if (L < 1496) return so.next(i, u);
        if (L < 1536) { u.pm = 34; u.pn = L - 1496; u.k0 = 0; u.nt = 0; u.ks = -1; return true; }
        const int j = L - 1536; if (j >= 192) return false;
        const int ti = j >> 2, ks = j & 3; if (ti < 44) { u.pm = 35; u.pn = ti; } else { u.pm = 34; u.pn = ti - 4; }
        u.k0 = ks * 512; u.nt = 8; u.ks = ks; return true;
    }
    __device__ __forceinline__ void a_ready(const pg8::Unit&) const {}
    __device__ __forceinline__ void done(const pg8::Unit&) const {}
};
struct EpiZ {
    static constexpr bool PERM = true, AFTER_DRAIN = false;
    bf16_t* Z; float* SLU;
    __device__ __forceinline__ void operator()(const f32x4 (&acc)[2][2][4][2], const pg8::Unit& u, int wr, int wc, int fr, int fq) const {
        const int r0 = wr * 64 + fr, c0 = wc * 32 + 8 * fq;
        if (u.ks < 0) {
#pragma unroll
            for (int ai = 0; ai < 2; ++ai)
#pragma unroll
                for (int m = 0; m < 4; ++m) { bf16_t* rowp = Z + (size_t)(u.pm * 256 + r0 + ai * 128 + m * 16) * (2 * DFF) + u.pn * 256 + c0;
#pragma unroll
                    for (int bj = 0; bj < 2; ++bj) { const f32x4 v0 = acc[ai][bj][m][0], v1 = acc[ai][bj][m][1];
                        u32x4 w; w.x = cvt_pk_bf16(v0[0], v0[1]); w.y = cvt_pk_bf16(v0[2], v0[3]); w.z = cvt_pk_bf16(v1[0], v1[1]); w.w = cvt_pk_bf16(v1[2], v1[3]);
                        *(u32x4*)(rowp + bj * 128) = w; } }
        } else {
            const int ti = (u.pm == 35) ? u.pn : u.pn + 4;
            float* base = SLU + (((size_t)u.ks * 48 + ti) * 256 + r0) * 256 + c0;
#pragma unroll
            for (int ai = 0; ai < 2; ++ai)
#pragma unroll
                for (int m = 0; m < 4; ++m) { float* rowp = base + (size_t)(ai * 128 + m * 16) * 256;
#pragma unroll
                    for (int bj = 0; bj < 2; ++bj) { *(f32x4*)(rowp + bj * 128) = acc[ai][bj][m][0]; *(f32x4*)(rowp + bj * 128 + 4) = acc[ai][bj][m][1]; } }
        }
    }
};
struct BrSplit {
    int c, br;
    __device__ bool next(int i, pg8::Unit& u) const {
        if (i > 0) return false;
        const int s = c & 7, b = s < 3 ? 0 : (s < 6 ? 1 : 2); if (b != br) return false;
        const int ti = c >> 3; u.pm = 32 + (ti >> 3); u.pn = ti & 7; u.k0 = (b == 0 ? s : (b == 1 ? s - 3 : s - 6)) * 256; u.nt = 4; u.ks = s; return true;
    }
    __device__ __forceinline__ void a_ready(const pg8::Unit&) const {}
    __device__ __forceinline__ void done(const pg8::Unit&) const {}
};
struct EpiBrS {
    static constexpr bool PERM = false, AFTER_DRAIN = false;
    float* SLAB; const bf16_t* GATE;
    __device__ __forceinline__ void operator()(const f32x4 (&acc)[2][2][4][2], const pg8::Unit& u, int wr, int wc, int fr, int fq) const {
        const int row0 = u.pm * 256 + wr * 64 + fr, col0 = u.pn * 256 + wc * 32 + 4 * fq;
#pragma unroll
        for (int ai = 0; ai < 2; ++ai)
#pragma unroll
            for (int m = 0; m < 4; ++m) { const size_t row = (size_t)(row0 + ai * 128 + m * 16);
#pragma unroll
                for (int bj = 0; bj < 2; ++bj)
#pragma unroll
                    for (int n = 0; n < 2; ++n) { const int c = col0 + bj * 128 + n * 16;
                        const u32x2 gw = *(const u32x2*)(GATE + row * PIN + c);
                        f32x4 v = acc[ai][bj][m][n]; v[0] *= bflo(gw.x); v[1] *= bfhi(gw.x); v[2] *= bflo(gw.y); v[3] *= bfhi(gw.y);
                        *(f32x4*)(SLAB + ((size_t)u.ks * 1024 + (row - 8192)) * DM + c) = v; } }
    }
};
__device__ __forceinline__ void transpose_item(const float* __restrict__ W, int K, int N, bf16_t* __restrict__ WT, float* scr, int item, int lane) {
    const int nblk = N / 64, kb = item / nblk, nb = item - kb * nblk, k0 = 64 * kb, n0 = 64 * nb;
    f32x4 v[16];
#pragma unroll
    for (int i = 0; i < 16; ++i) v[i] = __builtin_nontemporal_load((const f32x4*)(W + (size_t)(k0 + 4 * i + (lane >> 4)) * N + n0 + (lane & 15) * 4));
#pragma unroll
    for (int i = 0; i < 16; ++i) { float* d = scr + (4 * i + (lane >> 4)) * 65 + (lane & 15) * 4; d[0] = v[i][0]; d[1] = v[i][1]; d[2] = v[i][2]; d[3] = v[i][3]; }
    lds_fence();
    const int c = lane & 7;
#pragma unroll
    for (int j = 0; j < 8; ++j) { const int n = (lane >> 3) + 8 * j; const float* s = scr + (8 * c) * 65 + n;
        u32x4 o; o.x = cvt_pk_bf16(s[0 * 65], s[1 * 65]); o.y = cvt_pk_bf16(s[2 * 65], s[3 * 65]); o.z = cvt_pk_bf16(s[4 * 65], s[5 * 65]); o.w = cvt_pk_bf16(s[6 * 65], s[7 * 65]);
        *(u32x4*)(WT + (size_t)(n0 + n) * K + k0 + 8 * c) = o; }
    lds_fence();
}
__device__ __forceinline__ void rms_row_to_bf16(const float* __restrict__ xrow, const float* __restrict__ g, bf16_t* __restrict__ orow, int lane) {
    const f32x4* xr = (const f32x4*)xrow + lane; const f32x4* gr = (const f32x4*)g + lane;
    f32x4 v[8]; float s = 0.f;
#pragma unroll
    for (int j = 0; j < 8; ++j) { v[j] = xr[64 * j]; s += (v[j][0] * v[j][0] + v[j][1] * v[j][1]) + (v[j][2] * v[j][2] + v[j][3] * v[j][3]); }
    const float rs = rsqrtf(wave_sum(s) * (1.f / DM) + NEPS);
    u32x2* o8 = (u32x2*)orow + lane;
#pragma unroll
    for (int j = 0; j < 8; ++j) { const f32x4 gg = gr[64 * j]; u32x2 w; w.x = cvt_pk_bf16(v[j][0] * rs * gg[0], v[j][1] * rs * gg[1]); w.y = cvt_pk_bf16(v[j][2] * rs * gg[2], v[j][3] * rs * gg[3]); o8[64 * j] = w; }
}
__device__ __forceinline__ const float* xrow_ptr(const KArgs& a, int tok) { return tok < NPT ? a.in[0] + (size_t)tok * DM : a.in[1] + (size_t)(tok - NPT) * DM; }

__device__ __forceinline__ void phase0(const KArgs& a, unsigned char* lds, int tid, int wave, int lane) {
    unsigned char* ws = a.ws;
    float* scr = (float*)(lds + wave * 16640);
    const int gw = blockIdx.x * 8 + wave, NGW = gridDim.x * 8;
    constexpr int I_IN = 32 * (PIN / 64), I_MKV = 32 * 16;
    constexpr int NITEMS = I_IN + I_MKV;
    for (int it = gw; it < NITEMS; it += NGW) {
        if (it < I_IN) transpose_item(a.in[11], DM, PIN, (bf16_t*)(ws + WS_WT_IN), scr, it, lane);
        else transpose_item(a.in[25], DM, 1024, (bf16_t*)(ws + WS_WT_MEMKV), scr, it - I_IN, lane);
    }
    { bf16_t* wl = (bf16_t*)(ws + WS_WT_LR);
      for (int i = blockIdx.x * 512 + tid; i < 2304 * 256; i += gridDim.x * 512) { const int n = i >> 8, k = i & 255; float v = 0.f;
          if (n < 768) { if (k < 64) v = a.in[13][k * 768 + n]; }
          else if (n < 1536) { if (k >= 64 && k < 128) v = a.in[15][(k - 64) * 768 + (n - 768)]; }
          else { if (k >= 128) v = a.in[17][(k - 128) * 768 + (n - 1536)]; }
          wl[i] = f2bf(v); } }
    for (int m = gw; m < NTOK + 1024; m += NGW) {
        if (m < NTOK) rms_row_to_bf16(xrow_ptr(a, m), a.in[10], (bf16_t*)(ws + WS_XN) + (size_t)m * DM, lane);
        else rms_row_to_bf16(a.in[9] + (size_t)(m - NTOK) * DM, a.in[24], (bf16_t*)(ws + WS_MEMN) + (size_t)(m - NTOK) * DM, lane);
    }
}

template <int D, int NKB>
__device__ __forceinline__ void attn_wave(const unsigned char* Ks, int kpitch, const unsigned char* VTs, int vpitch, int kb_lo,
                                          const bf16_t* qptr, float scale, int lo, int hi, float sink, bool use_sink, bf16_t* optr, bool store, int lane) {
    const int l15 = lane & 15, q4 = lane >> 4;
    const float NINF = -__builtin_inff();
    bf16x8 qf[D / 32];
#pragma unroll
    for (int ks = 0; ks < D / 32; ++ks) qf[ks] = *(const bf16x8*)(qptr + ks * 32 + q4 * 8);
    f32x4 s[NKB];
#pragma unroll
    for (int kb = 0; kb < NKB; ++kb) { f32x4 acc = (f32x4){0.f, 0.f, 0.f, 0.f};
#pragma unroll
        for (int ks = 0; ks < D / 32; ++ks) { const bf16x8 kf = *(const bf16x8*)(Ks + (size_t)((kb_lo + kb) * 16 + l15) * kpitch + (ks * 32 + q4 * 8) * 2);
            acc = __builtin_amdgcn_mfma_f32_16x16x32_bf16(kf, qf[ks], acc, 0, 0, 0); }
        s[kb] = acc; }
    float m = use_sink ? sink : NINF;
#pragma unroll
    for (int kb = 0; kb < NKB; ++kb)
#pragma unroll
        for (int r = 0; r < 4; ++r) { const int j = (kb_lo + kb) * 16 + q4 * 4 + r; float v = s[kb][r] * scale; v = (j >= lo && j <= hi) ? v : NINF; s[kb][r] = v; m = fmaxf(m, v); }
    m = fmaxf(m, __shfl_xor(m, 16)); m = fmaxf(m, __shfl_xor(m, 32));
    if (m == NINF) m = 0.f;
    float sum = 0.f;
#pragma unroll
    for (int kb = 0; kb < NKB; ++kb)
#pragma unroll
        for (int r = 0; r < 4; ++r) { const float e = __expf(s[kb][r] - m); s[kb][r] = e; sum += e; }
    sum += __shfl_xor(sum, 16); sum += __shfl_xor(sum, 32);
    if (use_sink) sum += __expf(sink - m);
    const float inv = 1.f / sum;
    f32x4 o[D / 16];
#pragma unroll
    for (int db = 0; db < D / 16; ++db) o[db] = (f32x4){0.f, 0.f, 0.f, 0.f};
#pragma unroll
    for (int pr = 0; pr < NKB / 2; ++pr) {
        u32x4 pw; pw.x = cvt_pk_bf16(s[2 * pr][0], s[2 * pr][1]); pw.y = cvt_pk_bf16(s[2 * pr][2], s[2 * pr][3]);
        pw.z = cvt_pk_bf16(s[2 * pr + 1][0], s[2 * pr + 1][1]); pw.w = cvt_pk_bf16(s[2 * pr + 1][2], s[2 * pr + 1][3]);
        const bf16x8 pf = __builtin_bit_cast(bf16x8, pw);
#pragma unroll
        for (int db = 0; db < D / 16; ++db) { const unsigned char* vp = VTs + (size_t)(db * 16 + l15) * vpitch + (db * 2 + (l15 >> 3)) * 8 + ((kb_lo + 2 * pr) * 16 + q4 * 4) * 2;
            const u32x2 v0 = *(const u32x2*)vp, v1 = *(const u32x2*)(vp + 32);
            u32x4 vw; vw.x = v0.x; vw.y = v0.y; vw.z = v1.x; vw.w = v1.y;
            o[db] = __builtin_amdgcn_mfma_f32_16x16x32_bf16(__builtin_bit_cast(bf16x8, vw), pf, o[db], 0, 0, 0); } }
    if (store) {
#pragma unroll
        for (int db = 0; db < D / 16; ++db) { u32x2 w; w.x = cvt_pk_bf16(o[db][0] * inv, o[db][1] * inv); w.y = cvt_pk_bf16(o[db][2] * inv, o[db][3] * inv);
            *(u32x2*)(optr + db * 16 + q4 * 4) = w; } }
}
__device__ __forceinline__ void vt_write8(unsigned char* VTs, int vpitch, int key, int d0, u32x4 w) {
    unsigned short* p = (unsigned short*)(VTs + (size_t)d0 * vpitch + (d0 >> 3) * 8 + key * 2); const int st = vpitch >> 1;
    p[0] = (unsigned short)(w.x & 0xffffu); p[st] = (unsigned short)(w.x >> 16); p[2 * st] = (unsigned short)(w.y & 0xffffu); p[3 * st] = (unsigned short)(w.y >> 16);
    p[4 * st] = (unsigned short)(w.z & 0xffffu); p[5 * st] = (unsigned short)(w.z >> 16); p[6 * st] = (unsigned short)(w.w & 0xffffu); p[7 * st] = (unsigned short)(w.w >> 16);
}
__device__ __forceinline__ u32x4 pack8(const f32x4 a, const f32x4 b) { u32x4 w; w.x = cvt_pk_bf16(a[0], a[1]); w.y = cvt_pk_bf16(a[2], a[3]); w.z = cvt_pk_bf16(b[0], b[1]); w.w = cvt_pk_bf16(b[2], b[3]); return w; }

constexpr int KP64 = 144, KP128 = 272, VTP = 544;
constexpr int VT_OFF64 = 256 * KP64, VT_OFF128 = 256 * KP128;

__device__ __forceinline__ void attn_mem_sample(const KArgs& a, unsigned char* lds, int u, int tid, int wave, int lane) {
    unsigned char* ws = a.ws; const bf16_t* P = (const bf16_t*)(ws + WS_BIG); bf16_t* OMEM = (bf16_t*)(ws + WS_OMEM);

        const int b = u >> 2, h = u & 3;
        unsigned char* Ks = lds; unsigned char* VTs = lds + VT_OFF128;
#pragma unroll
        for (int it = 0; it < 8; ++it) { const int ch = tid + it * 512, j = ch >> 4, c8 = ch & 15;
            const size_t off = ((size_t)(b * 256 + j) * 4 + h) * 128 + c8 * 8;
            const u32x4 kv = pack8(*(const f32x4*)(a.in[4] + off), *(const f32x4*)(a.in[4] + off + 4)), vv = pack8(*(const f32x4*)(a.in[5] + off), *(const f32x4*)(a.in[5] + off + 4));
            *(u32x4*)(Ks + j * KP128 + c8 * 16) = kv; vt_write8(VTs, VTP, j, c8 * 8, vv); }
        __syncthreads();
        if (wave == 0) { const int t = lane & 15, tc = t < 8 ? t : 7; const int tok = NPT + b * 8 + tc;
            attn_wave<128, 16>(Ks, KP128, VTs, VTP, 0, P + (size_t)tok * PIN + C_QMEM + h * 128, 0.08838834764831845f, 0, 255, 0.f, false, OMEM + (size_t)tok * 512 + h * 128, t < 8, lane); }
        __syncthreads();
    }
__device__ __forceinline__ void phase2(const KArgs& a, unsigned char* lds, int tid, int wave, int lane) {
    unsigned char* ws = a.ws;
    const bf16_t* P = (const bf16_t*)(ws + WS_BIG);
    bf16_t* OSW = (bf16_t*)(ws + WS_OSW); bf16_t* OMEM = (bf16_t*)(ws + WS_OMEM);
    const bf16_t* MEMKV = (const bf16_t*)(ws + WS_MEMKV);
    const float* sinks = a.in[23];
    const u32x4 zero4 = (u32x4){0u, 0u, 0u, 0u};
    unsigned char* Ks = lds;
    const int ua = blockIdx.x, ab = ua >> 6, akvh = (ua >> 4) & 3, aqb = ua & 15;
    { u32x4 rk[4], rv[4];
#pragma unroll
      for (int it = 0; it < 4; ++it) { const int ch = tid + it * 512, jj = ch >> 3, c8 = ch & 7; const int pos = aqb * 128 - 128 + jj; const bool ok = pos >= 0;
          const bf16_t* src = P + (size_t)(ab * SEQ + (ok ? pos : 0)) * PIN + akvh * 64 + c8 * 8; rk[it] = *(const u32x4*)(src + C_KSW); rv[it] = *(const u32x4*)(src + C_VSW); }
#pragma unroll
      for (int it = 0; it < 4; ++it) { const int ch = tid + it * 512, jj = ch >> 3, c8 = ch & 7; const bool ok = aqb * 128 - 128 + jj >= 0;
          *(u32x4*)(Ks + jj * KP64 + c8 * 16) = ok ? rk[it] : zero4; vt_write8(lds + VT_OFF64, VTP, jj, c8 * 8, ok ? rv[it] : zero4); } }
    __syncthreads();
    f32x4 bk0[3], bk1[3], bv0[3], bv1[3];
#define P2_LOAD_B(UB) do { const int b_ = (UB) >> 2, kvh_ = (UB) & 3; _Pragma("unroll") for (int it = 0; it < 3; ++it) { const int ch = tid + it * 512; const int jj = ch >> 3, c8 = ch & 7; \
        if (jj < 128) { const size_t off = ((size_t)(b_ * 128 + jj) * 4 + kvh_) * 64 + c8 * 8; bk0[it] = *(const f32x4*)(a.in[2] + off); bk1[it] = *(const f32x4*)(a.in[2] + off + 4); bv0[it] = *(const f32x4*)(a.in[3] + off); bv1[it] = *(const f32x4*)(a.in[3] + off + 4); } \
        else if (jj < 136) { const bf16_t* src = P + (size_t)(NPT + b_ * 8 + (jj - 128)) * PIN + kvh_ * 64 + c8 * 8; bk0[it] = *(const f32x4*)(src + C_KSW); bv0[it] = *(const f32x4*)(src + C_VSW); } } } while (0)
#define P2_STORE_B() do { _Pragma("unroll") for (int it = 0; it < 3; ++it) { const int ch = tid + it * 512; if (ch < 1280) { const int jj = ch >> 3, c8 = ch & 7; u32x4 kv = zero4, vv = zero4; \
        if (jj < 128) { kv = pack8(bk0[it], bk1[it]); vv = pack8(bv0[it], bv1[it]); } else if (jj < 136) { kv = __builtin_bit_cast(u32x4, bk0[it]); vv = __builtin_bit_cast(u32x4, bv0[it]); } \
        *(u32x4*)(Ks + jj * KP64 + c8 * 16) = kv; vt_write8(lds + VT_OFF64, VTP, jj, c8 * 8, vv); } } } while (0)
#define P2_COMPUTE_B(UB) do { if (wave < 3) { const int b_ = (UB) >> 2, kvh_ = (UB) & 3; const int t = lane & 15, tc = t < 8 ? t : 7; const int hq = kvh_ * 3 + wave; const int tok = NPT + b_ * 8 + tc; \
        attn_wave<64, 10>(Ks, KP64, lds + VT_OFF64, VTP, 0, P + (size_t)tok * PIN + C_QSW + hq * 64, 0.125f, tc + 1, tc + 128, sinks[hq], true, OSW + (size_t)tok * 768 + hq * 64, t < 8, lane); } } while (0)
    const int ub1 = blockIdx.x, ub2 = blockIdx.x + 256;
    P2_LOAD_B(ub1);
    {
      const int qi = wave * 16 + (lane & 15); const int tok = ab * SEQ + aqb * 128 + qi;
      const int lo = (aqb == 0) ? (qi + 1 > 128 ? qi + 1 : 128) : qi + 1, hi = qi + 128;
      const int kb_lo = wave < 6 ? wave : 6;
#pragma unroll 1
      for (int g = 0; g < 3; ++g) { const int hq = akvh * 3 + g;
          attn_wave<64, 10>(Ks, KP64, lds + VT_OFF64, VTP, kb_lo, P + (size_t)tok * PIN + C_QSW + hq * 64, 0.125f, lo, hi, sinks[hq], true, OSW + (size_t)tok * 768 + hq * 64, true, lane); } }
    __syncthreads();
    P2_STORE_B();
    __syncthreads();
    P2_LOAD_B(ub2);
    P2_COMPUTE_B(ub1);
    __syncthreads();
    P2_STORE_B();
    __syncthreads();
    const int uc = blockIdx.x, cb = uc >> 6, chh = (uc >> 4) & 3, cqb = uc & 15;
    u32x4 ck[8], cv[8];
#pragma unroll
    for (int it = 0; it < 8; ++it) { const int ch = tid + it * 512, jj = ch >> 4, c8 = ch & 15;
        const bf16_t* src = MEMKV + (size_t)(cb * 256 + jj) * 1024 + chh * 128 + c8 * 8; ck[it] = *(const u32x4*)src; cv[it] = *(const u32x4*)(src + 512); }
    P2_COMPUTE_B(ub2);
    __syncthreads();
#pragma unroll
    for (int it = 0; it < 8; ++it) { const int ch = tid + it * 512, jj = ch >> 4, c8 = ch & 15;
        *(u32x4*)(Ks + jj * KP128 + c8 * 16) = ck[it]; vt_write8(lds + VT_OFF128, VTP, jj, c8 * 8, cv[it]); }
    __syncthreads();
    { const int tok = cb * SEQ + cqb * 128 + wave * 16 + (lane & 15);
      attn_wave<128, 16>(Ks, KP128, lds + VT_OFF128, VTP, 0, P + (size_t)tok * PIN + C_QMEM + chh * 128, 0.08838834764831845f, 0, 255, 0.f, false, OMEM + (size_t)tok * 512 + chh * 128, true, lane); }
    __syncthreads();
#undef P2_LOAD_B
#undef P2_STORE_B
#undef P2_COMPUTE_B
    { bf16_t* ALR = (bf16_t*)(ws + WS_ALR); const float* mu = a.in[12];
      for (int i0 = blockIdx.x * 512 + tid; i0 < (NTOK / 8) * 256; i0 += gridDim.x * 512) { const int tq = i0 >> 8, c = i0 & 255, col = 2304 + c, tok0 = tq * 8;
          unsigned up[8]; float prev;
#pragma unroll
          for (int q = 0; q < 8; ++q) up[q] = P[(size_t)(tok0 + q) * PIN + col];
          if (tok0 < NPT) prev = (tok0 & (SEQ - 1)) ? bf2f(P[(size_t)(tok0 - 1) * PIN + col]) : 0.f;
          else { const int st = tok0 - NPT; prev = (st & 7) ? bf2f(P[(size_t)(tok0 - 1) * PIN + col]) : a.in[6][(size_t)(st >> 3) * RWP + col]; }
          const float m = mu[col];
#pragma unroll
          for (int q = 0; q < 8; ++q) { const float p = bflo(up[q]); const float s = p + m * (prev - p); prev = p;
              float v; if (c < 64) { const float e = __expf(2.f * s); v = 1.f - 2.f * __builtin_amdgcn_rcpf(e + 1.f); } else if (c < 128) v = s; else v = sigmoidf_(s);
              ALR[(size_t)(tok0 + q) * 256 + c] = f2bf(v); } } }
}

constexpr int TC = 32;
constexpr int SCAN_BUF_FLOATS = TC * 320 + TC * 16 + 1024;
constexpr int SCAN_OUT_OFF = 2 * SCAN_BUF_FLOATS * 4;
#define SCAN_BAR() asm volatile("s_waitcnt lgkmcnt(0)\n\ts_barrier" ::: "memory")

struct SUnit { int tok0, len, b, h, rb; bool first, last, prompt; };
__device__ __forceinline__ SUnit scan_unit(int blk, int u) {
    SUnit s;
    if (blk < 192) { const int bh = blk >> 2; s.b = bh / 12; s.h = bh - s.b * 12; s.rb = blk & 3; s.tok0 = s.b * SEQ + u * TC; s.len = TC; s.first = (u == 0); s.last = (u == SEQ / TC - 1); s.prompt = true; }
    else { const int seq = u; s.b = seq / 12; s.h = seq - s.b * 12; s.rb = 0; s.tok0 = NPT + s.b * 8; s.len = 8; s.first = true; s.last = true; s.prompt = false; }
    return s;
}
struct LReg { unsigned pr[8], pk[8], pv[8], qr[8], qk[8], qv[8], de[8], aa[8]; f32x4 st[4]; float mu_r, mu_k, mu_v, kkc, kac, rkc, w0c, a0c, f_r, f_k, f_v; };
__device__ __forceinline__ void scan_load(const KArgs& a, const SUnit& s, int lw, int lane, int ltid, LReg& R) {
    const unsigned char* ws = a.ws;
    const bf16_t* P = (const bf16_t*)(ws + WS_BIG); const bf16_t* LRO = (const bf16_t*)(ws + WS_LRO);
    const int ch = s.h * 64 + lane;
    R.mu_r = a.in[12][ch]; R.mu_k = a.in[12][768 + ch]; R.mu_v = a.in[12][1536 + ch]; R.kkc = a.in[18][ch]; R.kac = a.in[19][ch]; R.rkc = a.in[20][ch]; R.w0c = a.in[14][ch]; R.a0c = a.in[16][ch];
    R.f_r = 0.f; R.f_k = 0.f; R.f_v = 0.f;
    if (!s.prompt) { const float* sh = a.in[6] + (size_t)s.b * RWP + ch; R.f_r = sh[0]; R.f_k = sh[768]; R.f_v = sh[1536]; }
#pragma unroll
    for (int i = 0; i < 8; ++i) { const int tt = lw + 4 * i; const int ttc = tt < s.len ? tt : 0; const int tok = s.tok0 + ttc; const bool is0 = s.first && ttc == 0;
        if (i < 2 || s.prompt) {
            const bf16_t* row = P + (size_t)tok * PIN + ch; const bf16_t* rowm = P + (size_t)(is0 ? tok : tok - 1) * PIN + ch;
            R.pr[i] = row[0]; R.pk[i] = row[768]; R.pv[i] = row[1536];
            R.qr[i] = rowm[0]; R.qk[i] = rowm[768]; R.qv[i] = rowm[1536];
            R.de[i] = LRO[(size_t)tok * 2304 + ch]; R.aa[i] = LRO[(size_t)tok * 2304 + 768 + ch]; } }
    if (!s.prompt) { const f32x4* src = (const f32x4*)(a.in[7] + (size_t)(s.b * 12 + s.h) * 4096) + ltid;
#pragma unroll
        for (int q = 0; q < 4; ++q) R.st[q] = src[256 * q]; }
}
__device__ __forceinline__ void scan_store(const KArgs& a, const SUnit& s, float* buf, int lw, int lane, int ltid, const LReg& R) {
    float* BON = (float*)(a.ws + WS_BONUS);
    if (!s.prompt) { f32x4* dst = (f32x4*)(buf + 3072) + ltid;
#pragma unroll
        for (int q = 0; q < 4; ++q) dst[256 * q] = R.st[q]; }
#pragma unroll
    for (int i = 0; i < 8; ++i) { const int tt = lw + 4 * i;
        if (tt < s.len) { const int tok = s.tok0 + tt;
            const bool is0 = s.first && tt == 0;
            const float x = R.w0c + bflo(R.de[i]); const float sp = fmaxf(-x, 0.f) + 0.6931471806f * __builtin_amdgcn_logf(1.f + __expf(-fabsf(x))); const float dec = __expf(-__expf(-sp - 0.5f)); const float av = sigmoidf_(R.a0c + bflo(R.aa[i]));
            const float pr = bflo(R.pr[i]), pk = bflo(R.pk[i]), pv = bflo(R.pv[i]);
            const float qr = is0 ? R.f_r : bflo(R.qr[i]), qk = is0 ? R.f_k : bflo(R.qk[i]), qv = is0 ? R.f_v : bflo(R.qv[i]);
            const float sr = pr + R.mu_r * (qr - pr), sk = pk + R.mu_k * (qk - pk), sv = pv + R.mu_v * (qv - pv);
            const float kk = sk * R.kkc; const float n2 = wave_sum(kk * kk); const float kkn = kk * __builtin_amdgcn_rsqf(fmaxf(n2, 1e-24f));
            const float kq = sk * (1.f + (av - 1.f) * R.kac);
            float* vb = buf + tt * 320;
            vb[lane] = dec; vb[64 + lane] = -kkn; vb[128 + lane] = kkn * av; vb[192 + lane] = kq; vb[256 + lane] = sr;
            if (s.prompt) { if ((lane >> 4) == s.rb) buf[TC * 320 + tt * 16 + (lane & 15)] = sv; } else buf[2560 + tt * 64 + lane] = sv;
            if (s.rb == 0) { const float bs = wave_sum(sr * kq * R.rkc); if (lane == 0) BON[(size_t)tok * 12 + s.h] = bs; } } }
}
__device__ __forceinline__ void scan_flush(const KArgs& a, const SUnit& s, const float* outb, int ltid) {
    float* ORAW = (float*)(a.ws + WS_ORAW);
#pragma unroll
    for (int r = 0; r < 2; ++r) { const int e = ltid + 256 * r; const f32x4 qd = *(const f32x4*)(outb + e * 4); const float v = (qd[0] + qd[1]) + (qd[2] + qd[3]);
        if (s.prompt) { const int t = e >> 4, i = e & 15; ORAW[(size_t)(s.tok0 + t) * 768 + s.h * 64 + s.rb * 16 + i] = v; }
        else { const int t = e >> 6, i = e & 63; ORAW[(size_t)(s.tok0 + t) * 768 + s.h * 64 + i] = v; } }
}
typedef float f32x2 __attribute__((ext_vector_type(2)));
struct SV { f32x4 W, NK, B, KQ, R; float vv; };
__device__ __forceinline__ void sv_load(SV& x, const float* VB, const float* VV, int vstr, int t, int kg) {
    const float* vn = VB + t * 320 + kg * 4;
    x.W = *(const f32x4*)(vn); x.NK = *(const f32x4*)(vn + 64); x.B = *(const f32x4*)(vn + 128); x.KQ = *(const f32x4*)(vn + 192); x.R = *(const f32x4*)(vn + 256); x.vv = VV[t * vstr];
}
__device__ __forceinline__ void sv_step(f32x4& S, const SV& x, float* optr) {
    f32x2 p = S.lo * x.NK.lo; p = S.hi * x.NK.hi + p;
    float sa = p.x + p.y;
    f32x2 u0 = S.lo * x.W.lo; DPP_ADD(sa, 0xB1);
    f32x2 u1 = S.hi * x.W.hi; DPP_ADD(sa, 0x4E);
    u0 = x.KQ.lo * x.vv + u0; DPP_ADD(sa, 0x141);
    u1 = x.KQ.hi * x.vv + u1; DPP_ADD(sa, 0x140);
    S.lo = x.B.lo * sa + u0; S.hi = x.B.hi * sa + u1;
    f32x2 q = S.lo * x.R.lo; q = S.hi * x.R.hi + q;
    float o = q.x + q.y; DPP_ADD(o, 0xB1); DPP_ADD(o, 0x4E);
    *optr = o;
}
__device__ __forceinline__ void scan_steps(f32x4& S, const float* VB, const float* VV, int vstr, float* OB, int ostr, int len, int kg) {
    const int last = len - 1;
    SV A, B;
    sv_load(A, VB, VV, vstr, 0, kg);
#pragma unroll 1
    for (int t = 0; t < len; t += 2) {
        sv_load(B, VB, VV, vstr, t + 1, kg); sv_step(S, A, OB + t * ostr);
        sv_load(A, VB, VV, vstr, (t + 2 < last) ? t + 2 : last, kg); sv_step(S, B, OB + (t + 1) * ostr);
    }
}
__device__ __forceinline__ void phase3b(const KArgs& a, int wave, int lane) {
    unsigned char* ws = a.ws;
    const bf16_t* P = (const bf16_t*)(ws + WS_BIG); const bf16_t* LRO = (const bf16_t*)(ws + WS_LRO); float* BON = (float*)(ws + WS_BONUS);
    float* PW = (float*)(ws + WS_PW); float* PNK = (float*)(ws + WS_PNK); bf16_t* PB = (bf16_t*)(ws + WS_PB); bf16_t* PKQ = (bf16_t*)(ws + WS_PKQ); bf16_t* PR = (bf16_t*)(ws + WS_PR); bf16_t* PV = (bf16_t*)(ws + WS_PV);
    const int gw = blockIdx.x * 8 + wave, NGW = gridDim.x * 8;
    for (int task0 = gw * 16; task0 < NPT * 12; task0 += NGW * 16) { const int h = task0 / NPT, tok0 = task0 - h * NPT, ch = h * 64 + lane;
        unsigned upr[16], upk[16], upv[16], ude[16], uaa[16]; unsigned uqr, uqk, uqv;
        const int t0 = tok0 & (SEQ - 1), b = tok0 >> 11;
        { const bf16_t* rowm = P + (size_t)(t0 ? tok0 - 1 : tok0) * PIN + ch; uqr = rowm[0]; uqk = rowm[768]; uqv = rowm[1536]; }
#pragma unroll
        for (int q = 0; q < 16; ++q) { const bf16_t* row = P + (size_t)(tok0 + q) * PIN + ch; upr[q] = row[0]; upk[q] = row[768]; upv[q] = row[1536];
            ude[q] = LRO[(size_t)(tok0 + q) * 2304 + ch]; uaa[q] = LRO[(size_t)(tok0 + q) * 2304 + 768 + ch]; }
        const float w0c = a.in[14][ch], a0c = a.in[16][ch], mu_r = a.in[12][ch], mu_k = a.in[12][768 + ch], mu_v = a.in[12][1536 + ch], kkc = a.in[18][ch], kac = a.in[19][ch], rkc = a.in[20][ch];
        float qr = t0 ? bflo(uqr) : 0.f, qk = t0 ? bflo(uqk) : 0.f, qv = t0 ? bflo(uqv) : 0.f;
#pragma unroll
        for (int q = 0; q < 16; ++q) { const int tok = tok0 + q;
            const float pr = bflo(upr[q]), pk = bflo(upk[q]), pv = bflo(upv[q]);
            const float x = w0c + bflo(ude[q]); const float sp = fmaxf(-x, 0.f) + 0.6931471806f * __builtin_amdgcn_logf(1.f + __expf(-fabsf(x))); const float dec = __expf(-__expf(-sp - 0.5f)); const float av = sigmoidf_(a0c + bflo(uaa[q]));
            const float sr = pr + mu_r * (qr - pr), sk = pk + mu_k * (qk - pk), sv = pv + mu_v * (qv - pv);
            qr = pr; qk = pk; qv = pv;
            const float kk = sk * kkc; const float n2 = wave_sum(kk * kk); const float kkn = kk * __builtin_amdgcn_rsqf(fmaxf(n2, 1e-24f));
            const float kq = sk * (1.f + (av - 1.f) * kac);
            const size_t idx = ((size_t)(b * 12 + h) * SEQ + (t0 + q)) * 64 + lane;
            PW[idx] = dec; PNK[idx] = -kkn; PB[idx] = f2bf(kkn * av); PKQ[idx] = f2bf(kq); PR[idx] = f2bf(sr); PV[idx] = f2bf(sv);
            const float bs = wave_sum(sr * kq * rkc); if (lane == 0) BON[(size_t)tok * 12 + h] = bs; } }
}
struct CReg { f32x4 w0, w1, n0, n1; u32x4 b, kq, r; unsigned v; };
__device__ __forceinline__ void copy_load(const unsigned char* ws, int bh, int rb, int u, int ltid, CReg& C) {
    const size_t base = ((size_t)bh * SEQ + (size_t)u * TC) * 64;
    const f32x4* Wg = (const f32x4*)(ws + WS_PW) + base / 4; const f32x4* Ng = (const f32x4*)(ws + WS_PNK) + base / 4;
    C.w0 = Wg[ltid]; C.w1 = Wg[ltid + 256]; C.n0 = Ng[ltid]; C.n1 = Ng[ltid + 256];
    C.b = ((const u32x4*)(ws + WS_PB) + base / 8)[ltid]; C.kq = ((const u32x4*)(ws + WS_PKQ) + base / 8)[ltid]; C.r = ((const u32x4*)(ws + WS_PR) + base / 8)[ltid];
    C.v = ((const unsigned*)(ws + WS_PV) + base / 2)[(ltid >> 3) * 32 + rb * 8 + (ltid & 7)];
}
__device__ __forceinline__ void store8(float* d, const u32x4 w) { *(f32x4*)d = (f32x4){bflo(w.x), bfhi(w.x), bflo(w.y), bfhi(w.y)}; *(f32x4*)(d + 4) = (f32x4){bflo(w.z), bfhi(w.z), bflo(w.w), bfhi(w.w)}; }
__device__ __forceinline__ void copy_store(float* buf, int ltid, const CReg& C) {
    { const int e = ltid * 4, t = e >> 6, k = e & 63; *(f32x4*)(buf + t * 320 + k) = C.w0; *(f32x4*)(buf + t * 320 + 64 + k) = C.n0; }
    { const int e = (ltid + 256) * 4, t = e >> 6, k = e & 63; *(f32x4*)(buf + t * 320 + k) = C.w1; *(f32x4*)(buf + t * 320 + 64 + k) = C.n1; }
    { const int t = ltid >> 3, k = (ltid & 7) * 8; float* d = buf + t * 320 + k; store8(d + 128, C.b); store8(d + 192, C.kq); store8(d + 256, C.r);
      float* vd = buf + TC * 320 + t * 16 + (ltid & 7) * 2; vd[0] = bflo(C.v); vd[1] = bfhi(C.v); }
}
constexpr int LT_UP = 64 * 176, LT_DN = 176 * 32, LT_O = 64 * 32, LT_B01 = 24 * 32, LT_B2 = 16 * 32, LT_TOTAL = LT_UP + LT_DN + LT_O + 2 * LT_B01 + LT_B2;
struct LtItem { const float* W; bf16_t* WT; int K, N, kb, nb; };
__device__ __forceinline__ LtItem lt_decode(const KArgs& a, int it) {
    LtItem d; unsigned char* ws = a.ws; int nblk;
    if (it < LT_UP) { d.W = a.in[32]; d.WT = (bf16_t*)(ws + WS_WT_UP); d.K = DM; d.N = 2 * DFF; nblk = 176; }
    else if ((it -= LT_UP) < LT_DN) { d.W = a.in[35]; d.WT = (bf16_t*)(ws + WS_WT_DN); d.K = DFF; d.N = DM; nblk = 32; }
    else if ((it -= LT_DN) < LT_O) { d.W = a.in[29]; d.WT = (bf16_t*)(ws + WS_WT_O); d.K = DM; d.N = DM; nblk = 32; }
    else if ((it -= LT_O) < LT_B01) { d.W = a.in[26]; d.WT = (bf16_t*)(ws + WS_WT_BR0); d.K = 768; d.N = DM; nblk = 32; }
    else if ((it -= LT_B01) < LT_B01) { d.W = a.in[27]; d.WT = (bf16_t*)(ws + WS_WT_BR1); d.K = 768; d.N = DM; nblk = 32; }
    else { it -= LT_B01; d.W = a.in[28]; d.WT = (bf16_t*)(ws + WS_WT_BR2); d.K = 512; d.N = DM; nblk = 32; }
    d.kb = it / nblk; d.nb = it - d.kb * nblk; return d;
}
__device__ __forceinline__ void lt_load(const KArgs& a, int it, int lane, f32x4 (&v)[8]) {
    if (it < LT_TOTAL) { const LtItem d = lt_decode(a, it); const float* src = d.W + (size_t)(32 * d.kb + (lane >> 4)) * d.N + 64 * d.nb + (lane & 15) * 4;
#pragma unroll
        for (int i = 0; i < 8; ++i) v[i] = __builtin_nontemporal_load((const f32x4*)(src + (size_t)(4 * i) * d.N)); }
}
__device__ __forceinline__ void lt_store(const KArgs& a, int it, float* scr, int lane, const f32x4 (&v)[8]) {
    if (it < LT_TOTAL) { const LtItem d = lt_decode(a, it);
#pragma unroll
        for (int i = 0; i < 8; ++i) { float* p = scr + (4 * i + (lane >> 4)) * 65 + (lane & 15) * 4; p[0] = v[i][0]; p[1] = v[i][1]; p[2] = v[i][2]; p[3] = v[i][3]; }
        lds_fence();
        const int c = lane & 3;
#pragma unroll
        for (int j = 0; j < 4; ++j) { const int n = (lane >> 2) + 16 * j; const float* s = scr + (8 * c) * 65 + n;
            u32x4 o; o.x = cvt_pk_bf16(s[0 * 65], s[1 * 65]); o.y = cvt_pk_bf16(s[2 * 65], s[3 * 65]); o.z = cvt_pk_bf16(s[4 * 65], s[5 * 65]); o.w = cvt_pk_bf16(s[6 * 65], s[7 * 65]);
            *(u32x4*)(d.WT + (size_t)(64 * d.nb + n) * d.K + 32 * d.kb + 8 * c) = o; }
        lds_fence(); }
}
constexpr int CP_A = 131072 / 256, CP_B = 4194304 / 256, CP_C = (4 * RWP + 255) / 256, CP_D = (128 * RWP + 255) / 256, CP_TOTAL = CP_A + CP_B + CP_C + CP_D;
__device__ __forceinline__ void copy_item(const KArgs& a, int it, int lane) {
    if (it >= CP_TOTAL) return;
    const bf16_t* P = (const bf16_t*)(a.ws + WS_BIG); float* out = a.out;
    if (it < CP_A) { const int e = (it * 64 + lane) * 4, b = e >> 15, r = (e >> 8) & 127, c = e & 255; const size_t src = (size_t)(b * SEQ + 1920 + r) * PIN + c;
        const u32x2 kw = *(const u32x2*)(P + src + C_KSW), vw = *(const u32x2*)(P + src + C_VSW);
        *(f32x4*)(out + O_SWAK_P + e) = (f32x4){bflo(kw.x), bfhi(kw.x), bflo(kw.y), bfhi(kw.y)}; *(f32x4*)(out + O_SWAV_P + e) = (f32x4){bflo(vw.x), bfhi(vw.x), bflo(vw.y), bfhi(vw.y)}; return; }
    it -= CP_A;
    if (it < CP_B) { const int e = (it * 64 + lane) * 4, b = e >> 15, r = (e >> 8) & 127, c = e & 255; f32x4 kv, vv;
        if (r < 120) { kv = *(const f32x4*)(a.in[2] + (size_t)(b * 128 + r + 8) * 256 + c); vv = *(const f32x4*)(a.in[3] + (size_t)(b * 128 + r + 8) * 256 + c); }
        else { const size_t src = (size_t)(NPT + b * 8 + (r - 120)) * PIN + c; const u32x2 kw = *(const u32x2*)(P + src + C_KSW), vw = *(const u32x2*)(P + src + C_VSW);
            kv = (f32x4){bflo(kw.x), bfhi(kw.x), bflo(kw.y), bfhi(kw.y)}; vv = (f32x4){bflo(vw.x), bfhi(vw.x), bflo(vw.y), bfhi(vw.y)}; }
        *(f32x4*)(out + O_SWAK_S + e) = kv; *(f32x4*)(out + O_SWAV_S + e) = vv; return; }
    it -= CP_B;
    if (it < CP_C) { for (int q = 0; q < 4; ++q) { const int i = (it * 64 + lane) * 4 + q; if (i < 4 * RWP) { const int b = i / RWP, c = i - b * RWP; out[O_SHIFT_P + i] = bf2f(P[(size_t)(b * SEQ + SEQ - 1) * PIN + c]); } } return; }
    it -= CP_C;
    for (int q = 0; q < 4; ++q) { const int i = (it * 64 + lane) * 4 + q; if (i < 128 * RWP) { const int b = i / RWP, c = i - b * RWP; out[O_SHIFT_S + i] = bf2f(P[(size_t)(NPT + b * 8 + 7) * PIN + c]); } }
}
__device__ __forceinline__ void phase4(const KArgs& a, unsigned char* lds, int tid, int wave, int lane) {
    const int blk = blockIdx.x;
    float* bufs = (float*)lds; float* outs = (float*)(lds + SCAN_OUT_OFF);
    const int rs = lane >> 4, kg = lane & 15, w4 = wave & 3, ltid = tid - 256;
    if (blk < 192) {
        const int bh = blk >> 2, rb = blk & 3; constexpr int NU = SEQ / TC;
        f32x4 S = (f32x4){0.f, 0.f, 0.f, 0.f};
        CReg C;
        f32x4 tv[8]; float* tscr = (float*)(lds + 110592 + w4 * 8320); const int lt0 = blk * 4 + w4;
        if (wave >= 4) { copy_load(a.ws, bh, rb, 0, ltid, C); copy_store(bufs, ltid, C); copy_load(a.ws, bh, rb, 1, ltid, C); lt_load(a, lt0, lane, tv); }
        SCAN_BAR();
#pragma unroll 1
        for (int u = 0; u < NU; ++u) {
            if (wave < 4) { const int rl = w4 * 4 + rs; const float* VB = bufs + (u & 1) * SCAN_BUF_FLOATS; float* OB = outs + (u & 1) * 2048;
                scan_steps(S, VB, VB + TC * 320 + rl, 16, OB + rl * 4 + (kg >> 2), 64, TC, kg);
                if (u == NU - 1) *(f32x4*)(a.out + O_WKV_P + ((size_t)bh * 64 + rb * 16 + rl) * 64 + kg * 4) = S;
            } else {
                copy_store(bufs + ((u + 1) & 1) * SCAN_BUF_FLOATS, ltid, C);
                copy_load(a.ws, bh, rb, (u + 2 < NU) ? u + 2 : NU - 1, ltid, C);
                if (u > 0) { const SUnit sp = scan_unit(blk, u - 1); scan_flush(a, sp, outs + ((u - 1) & 1) * 2048, ltid); }
                lt_store(a, lt0 + 768 * u, tscr, lane, tv);
                lt_load(a, lt0 + 768 * (u + 1), lane, tv);
                if (u >= 28) copy_item(a, lt0 + 768 * (u - 28), lane);
            }
            SCAN_BAR();
        }
        if (wave >= 4) { const SUnit sp = scan_unit(blk, NU - 1); scan_flush(a, sp, outs + ((NU - 1) & 1) * 2048, ltid); }
        SCAN_BAR();
    }
    {
        const int NU = blk < 192 ? 0 : 24, q0 = blk < 192 ? 0 : (blk - 192) * 24;
        LReg R;
        if (wave >= 4 && NU > 0) { const SUnit s0 = scan_unit(999, q0); scan_load(a, s0, w4, lane, ltid, R); scan_store(a, s0, bufs, w4, lane, ltid, R);
            const SUnit s1 = scan_unit(999, q0 + 1); scan_load(a, s1, w4, lane, ltid, R); }
        SCAN_BAR();
#pragma unroll 1
        for (int u = 0; u < NU; ++u) {
            if (wave < 4) { const SUnit s = scan_unit(999, q0 + u); const float* VB = bufs + (u & 1) * SCAN_BUF_FLOATS; float* OB = outs + (u & 1) * 2048;
#pragma unroll 1
                for (int p = 0; p < 4; ++p) { const int row = w4 * 16 + p * 4 + rs;
                    f32x4 T = *(const f32x4*)(VB + 3072 + row * 64 + kg * 4);
                    scan_steps(T, VB, VB + 2560 + row, 64, OB + row * 4 + (kg >> 2), 256, 8, kg);
                    *(f32x4*)(a.out + O_WKV_S + ((size_t)(s.b * 12 + s.h) * 64 + row) * 64 + kg * 4) = T; }
            } else {
                if (u + 1 < NU) { const SUnit sn = scan_unit(999, q0 + u + 1); scan_store(a, sn, bufs + ((u + 1) & 1) * SCAN_BUF_FLOATS, w4, lane, ltid, R); }
                if (u + 2 < NU) { const SUnit sn2 = scan_unit(999, q0 + u + 2); scan_load(a, sn2, w4, lane, ltid, R); }
                if (u > 0) { const SUnit sp = scan_unit(999, q0 + u - 1); scan_flush(a, sp, outs + ((u - 1) & 1) * 2048, ltid); }
            }
            SCAN_BAR();
        }
        if (wave >= 4 && NU > 0) { const SUnit sp = scan_unit(999, q0 + NU - 1); scan_flush(a, sp, outs + ((NU - 1) & 1) * 2048, ltid); }
    }
    __syncthreads();
    if (blk >= 192) { for (int u = blk - 192; u < 512; u += 64) attn_mem_sample(a, lds, u, tid, wave, lane); }
    __syncthreads();
}
__device__ __forceinline__ void phase5(const KArgs& a, int wave, int lane) {
    const unsigned char* ws = a.ws;
    const bf16_t* P = (const bf16_t*)(ws + WS_BIG); const float* ORAW = (const float*)(ws + WS_ORAW); const bf16_t* LRO = (const bf16_t*)(ws + WS_LRO); const float* BON = (const float*)(ws + WS_BONUS);
    bf16_t* ORW = (bf16_t*)(a.ws + WS_ORW);
    const int gw = blockIdx.x * 8 + wave, NGW = gridDim.x * 8;
    for (int task0 = gw * 16; task0 < NTOK * 12; task0 += NGW * 16) { const int h = task0 / NTOK, tok0 = task0 - h * NTOK, ch = h * 64 + lane;
        float o[16], bon[16], shf[16]; unsigned upv[16], uqv[16], ug[16];
#pragma unroll
        for (int q = 0; q < 16; ++q) { const int tok = tok0 + q; bool is0; int bb = 0;
            if (tok < NPT) is0 = (tok & (SEQ - 1)) == 0; else { const int st = tok - NPT; is0 = (st & 7) == 0; bb = st >> 3; }
            o[q] = ORAW[(size_t)tok * 768 + ch]; upv[q] = P[(size_t)tok * PIN + 1536 + ch]; uqv[q] = P[(size_t)(is0 ? tok : tok - 1) * PIN + 1536 + ch];
            ug[q] = LRO[(size_t)tok * 2304 + 1536 + ch]; bon[q] = BON[(size_t)tok * 12 + h];
            shf[q] = (is0 && tok >= NPT) ? a.in[6][(size_t)bb * RWP + 1536 + ch] : 0.f; }
        const float lw = a.in[21][ch], lb = a.in[22][ch], muv = a.in[12][1536 + ch];
#pragma unroll
        for (int q = 0; q < 16; ++q) { const int tok = tok0 + q; const bool is0 = (tok < NPT) ? ((tok & (SEQ - 1)) == 0) : (((tok - NPT) & 7) == 0);
            const float mean = wave_sum(o[q]) * (1.f / 64.f); const float d = o[q] - mean; const float var = wave_sum(d * d) * (1.f / 64.f);
            const float on = d * __builtin_amdgcn_rsqf(var + 6.4e-4f) * lw + lb;
            const float pv = bflo(upv[q]); const float qv = is0 ? shf[q] : bflo(uqv[q]);
            const float sv = pv + muv * (qv - pv);
            ORW[(size_t)tok * 768 + ch] = f2bf((on + bon[q] * sv) * bflo(ug[q])); } }
}
__device__ __forceinline__ void row_vals8(const bf16_t* T, const float* SLAB, int m, int col, float (&v)[8]) {
    if (m < NPT) { const u32x4 w = *(const u32x4*)(T + (size_t)m * DM + col); v[0] = bflo(w.x); v[1] = bfhi(w.x); v[2] = bflo(w.y); v[3] = bfhi(w.y); v[4] = bflo(w.z); v[5] = bfhi(w.z); v[6] = bflo(w.w); v[7] = bfhi(w.w); }
    else { const float* sl = SLAB + (size_t)(m - NPT) * DM + col; f32x4 t0 = *(const f32x4*)sl, t1 = *(const f32x4*)(sl + 4);
#pragma unroll
        for (int ks = 1; ks < 8; ++ks) { t0 += *(const f32x4*)(sl + (size_t)ks * 1024 * DM); t1 += *(const f32x4*)(sl + (size_t)ks * 1024 * DM + 4); }
#pragma unroll
        for (int e = 0; e < 4; ++e) { v[e] = t0[e]; v[4 + e] = t1[e]; } }
}
__device__ __forceinline__ void phase8(const KArgs& a, int wave, int lane) {
    unsigned char* ws = a.ws; const bf16_t* T1 = (const bf16_t*)(ws + WS_MRG); const float* SLAB = (const float*)(ws + WS_SLAB); bf16_t* H = (bf16_t*)(ws + WS_H); bf16_t* HN = (bf16_t*)(ws + WS_XN);
    const int gw = blockIdx.x * 8 + wave, NGW = gridDim.x * 8;
    for (int m = gw; m < NTOK; m += NGW) {
        const float* xr = xrow_ptr(a, m);
        float v[4][8]; float s = 0.f;
#pragma unroll
        for (int j = 0; j < 4; ++j) { row_vals8(T1, SLAB, m, j * 512 + lane * 8, v[j]);
#pragma unroll
            for (int e = 0; e < 8; ++e) s += v[j][e] * v[j][e]; }
        const float rs = rsqrtf(wave_sum(s) * (1.f / DM) + NEPS); float s2 = 0.f;
#pragma unroll
        for (int j = 0; j < 4; ++j) { const int col = j * 512 + lane * 8;
            const f32x4 x0 = __builtin_nontemporal_load((const f32x4*)(xr + col)), x1 = __builtin_nontemporal_load((const f32x4*)(xr + col + 4)), g0 = *(const f32x4*)(a.in[30] + col), g1 = *(const f32x4*)(a.in[30] + col + 4);
#pragma unroll
            for (int e = 0; e < 4; ++e) { v[j][e] = x0[e] + v[j][e] * rs * g0[e]; v[j][4 + e] = x1[e] + v[j][4 + e] * rs * g1[e]; }
#pragma unroll
            for (int e = 0; e < 8; ++e) s2 += v[j][e] * v[j][e];
            u32x4 w; w.x = cvt_pk_bf16(v[j][0], v[j][1]); w.y = cvt_pk_bf16(v[j][2], v[j][3]); w.z = cvt_pk_bf16(v[j][4], v[j][5]); w.w = cvt_pk_bf16(v[j][6], v[j][7]);
            *(u32x4*)(H + (size_t)m * DM + col) = w; }
        const float rs2 = rsqrtf(wave_sum(s2) * (1.f / DM) + NEPS);
#pragma unroll
        for (int j = 0; j < 4; ++j) { const int col = j * 512 + lane * 8; const f32x4 g0 = *(const f32x4*)(a.in[31] + col), g1 = *(const f32x4*)(a.in[31] + col + 4);
            u32x4 w; w.x = cvt_pk_bf16(v[j][0] * rs2 * g0[0], v[j][1] * rs2 * g0[1]); w.y = cvt_pk_bf16(v[j][2] * rs2 * g0[2], v[j][3] * rs2 * g0[3]);
            w.z = cvt_pk_bf16(v[j][4] * rs2 * g1[0], v[j][5] * rs2 * g1[1]); w.w = cvt_pk_bf16(v[j][6] * rs2 * g1[2], v[j][7] * rs2 * g1[3]);
            *(u32x4*)(HN + (size_t)m * DM + col) = w; }
    }
}
__device__ __forceinline__ float gelu_tanh(float x) { const float u = 0.7978845608028654f * (x + 0.044715f * x * x * x); const float e = __expf(2.f * u); const float th = 1.f - 2.f * __builtin_amdgcn_rcpf(e + 1.f); return 0.5f * x * (1.f + th); }
__device__ __forceinline__ void unpack8(const u32x4 w, float (&f)[8]) { f[0] = bflo(w.x); f[1] = bfhi(w.x); f[2] = bflo(w.y); f[3] = bfhi(w.y); f[4] = bflo(w.z); f[5] = bfhi(w.z); f[6] = bflo(w.w); f[7] = bfhi(w.w); }
template <bool SL> __device__ __forceinline__ void z_ld(const bf16_t* Z, const float* SLU, int tok, int col, float (&v)[8]) {
    if (!SL) { unpack8(__builtin_nontemporal_load((const u32x4*)(Z + (size_t)tok * (2 * DFF) + col)), v); }
    else { const int pm = tok >> 8, pn = col >> 8; const int ti = (pm == 35) ? pn : pn + 4; const float* p = SLU + ((size_t)ti * 256 + (tok & 255)) * 256 + (col & 255);
        f32x4 t0 = *(const f32x4*)p, t1 = *(const f32x4*)(p + 4);
#pragma unroll
        for (int ks = 1; ks < 4; ++ks) { t0 += *(const f32x4*)(p + (size_t)ks * 48 * 65536); t1 += *(const f32x4*)(p + (size_t)ks * 48 * 65536 + 4); }
#pragma unroll
        for (int e = 0; e < 4; ++e) { v[e] = t0[e]; v[4 + e] = t1[e]; } }
}
__device__ __forceinline__ bool z_is_slab(int tok, int col) { const int pm = tok >> 8; return pm == 35 || (pm == 34 && (col >> 8) >= 40); }
template <bool SG, bool SV> __device__ __forceinline__ void conv_item(const KArgs& a, const bf16_t* Z, const float* SLU, bf16_t* ACT, float* out, const float* st8, int tokb, int c,
                                                                      const float (&w0)[8], const float (&w1)[8], const float (&w2)[8], const float (&bb)[8], float (&z1)[8], float (&z2)[8], int ntrips) {
    const bool smp = tokb >= NPT;
#pragma unroll 1
    for (int k4 = 0; k4 < ntrips; ++k4) { const int tok0 = tokb + k4 * 4;
        float zg[4][8], zw[4][8];
#pragma unroll
        for (int q = 0; q < 4; ++q) { if (!SG) z_ld<false>(Z, SLU, tok0 + q, c, zg[q]); if (!SV) z_ld<false>(Z, SLU, tok0 + q, DFF + c, zw[q]); }
        f32x4 s0a, s0b, s1a, s1b;
        const bool sstart = smp && ((tok0 & 7) == 0);
        if (sstart) { const float* p = st8 + (size_t)((tok0 - NPT) >> 3) * 2 * DFF + c; s0a = *(const f32x4*)p; s0b = *(const f32x4*)(p + 4); s1a = *(const f32x4*)(p + DFF); s1b = *(const f32x4*)(p + DFF + 4); }
        else { s0a = (f32x4){0.f, 0.f, 0.f, 0.f}; s0b = s0a; s1a = s0a; s1b = s0a; }
#pragma unroll
        for (int q = 0; q < 4; ++q) { const int tok = tok0 + q; float (&z0)[8] = zg[q]; float (&zv)[8] = zw[q];
            if (SG) { z_ld<true>(Z, SLU, tok, c, z0); asm volatile("" ::: "memory"); } if (SV) { z_ld<true>(Z, SLU, tok, DFF + c, zv); asm volatile("" ::: "memory"); }
            if (q == 0 && sstart) {
#pragma unroll
                for (int j = 0; j < 4; ++j) { z2[j] = s0a[j]; z2[j + 4] = s0b[j]; z1[j] = s1a[j]; z1[j + 4] = s1b[j]; } }
            float r[8];
#pragma unroll
            for (int j = 0; j < 8; ++j) { const float cv = bb[j] + w0[j] * z2[j] + w1[j] * z1[j] + w2[j] * z0[j]; r[j] = gelu_tanh(cv) * zv[j]; }
            u32x4 w; w.x = cvt_pk_bf16(r[0], r[1]); w.y = cvt_pk_bf16(r[2], r[3]); w.z = cvt_pk_bf16(r[4], r[5]); w.w = cvt_pk_bf16(r[6], r[7]);
            *(u32x4*)(ACT + (size_t)tok * DFF + c) = w;
            int t, T, b; if (!smp) { t = tok & (SEQ - 1); T = SEQ; b = tok >> 11; } else { const int st = tok - NPT; t = st & 7; T = 8; b = st >> 3; }
            if (t >= T - 2) { float* dst = out + (smp ? O_CONV_S : O_CONV_P) + ((size_t)b * 2 + (t - (T - 2))) * DFF + c;
                *(f32x4*)dst = (f32x4){z0[0], z0[1], z0[2], z0[3]}; *(f32x4*)(dst + 4) = (f32x4){z0[4], z0[5], z0[6], z0[7]}; }
#pragma unroll
            for (int j = 0; j < 8; ++j) { z2[j] = z1[j]; z1[j] = z0[j]; } } }
}
__device__ __forceinline__ void phase10(const KArgs& a, int tid) {
    unsigned char* ws = a.ws; const bf16_t* Z = (const bf16_t*)(ws + WS_BIG); const float* SLU = (const float*)(ws + WS_SLU); bf16_t* ACT = (bf16_t*)(ws + WS_ACT); float* out = a.out;
    const float* cw = a.in[33]; const float* cb = a.in[34]; const float* st8 = a.in[8];
    constexpr int N_LONG = 136 * 704, N_ITEMS = N_LONG + 32 * 704;
    for (int it = blockIdx.x * 512 + tid; it < N_ITEMS; it += gridDim.x * 512) {
        int tokb, c, ntrips;
        if (it < N_LONG) { const int run = 135 - it / 704; c = (it % 704) * 8; tokb = run * 64; ntrips = 16; }
        else { const int i2 = it - N_LONG, run = i2 / 704; c = (i2 - run * 704) * 8; tokb = 8704 + run * 16; ntrips = 4; }
        float w0[8], w1[8], w2[8], bb[8];
#pragma unroll
        for (int j = 0; j < 8; ++j) { bb[j] = cb[c + j]; w0[j] = cw[c + j]; w1[j] = cw[DFF + c + j]; w2[j] = cw[2 * DFF + c + j]; }
        float z1[8], z2[8];
        { const int t = (tokb >= NPT) ? 0 : (tokb & (SEQ - 1));
          if (t >= 2) { z_ld<false>(Z, SLU, tokb - 1, c, z1); z_ld<false>(Z, SLU, tokb - 2, c, z2); }
          else {
#pragma unroll
              for (int j = 0; j < 8; ++j) { z1[j] = 0.f; z2[j] = 0.f; } } }
        const bool sg = z_is_slab(tokb, c), sv = z_is_slab(tokb, DFF + c);
        if (!sv) conv_item<false, false>(a, Z, SLU, ACT, out, st8, tokb, c, w0, w1, w2, bb, z1, z2, ntrips);
        else if (!sg) conv_item<false, true>(a, Z, SLU, ACT, out, st8, tokb, c, w0, w1, w2, bb, z1, z2, ntrips);
        else conv_item<true, true>(a, Z, SLU, ACT, out, st8, tokb, c, w0, w1, w2, bb, z1, z2, ntrips);
    }
}
__device__ __forceinline__ void phase12(const KArgs& a, int wave, int lane) {
    const unsigned char* ws = a.ws; const bf16_t* F = (const bf16_t*)(ws + WS_MRG); const float* SLAB = (const float*)(ws + WS_SLAB); const bf16_t* H = (const bf16_t*)(ws + WS_H);
    const int gw = blockIdx.x * 8 + wave, NGW = gridDim.x * 8;
    for (int m = gw; m < NTOK; m += NGW) {
        float v[4][8]; float s = 0.f; u32x4 hw[4];
#pragma unroll
        for (int j = 0; j < 4; ++j) { row_vals8(F, SLAB, m, j * 512 + lane * 8, v[j]); hw[j] = *(const u32x4*)(H + (size_t)m * DM + j * 512 + lane * 8);
#pragma unroll
            for (int e = 0; e < 8; ++e) s += v[j][e] * v[j][e]; }
        const float rs = rsqrtf(wave_sum(s) * (1.f / DM) + NEPS);
#pragma unroll
        for (int j = 0; j < 4; ++j) { const int col = j * 512 + lane * 8; const f32x4 g0 = *(const f32x4*)(a.in[36] + col), g1 = *(const f32x4*)(a.in[36] + col + 4);
            float h[8]; unpack8(hw[j], h);
            f32x4 y0, y1;
#pragma unroll
            for (int e = 0; e < 4; ++e) { y0[e] = h[e] + v[j][e] * rs * g0[e]; y1[e] = h[4 + e] + v[j][4 + e] * rs * g1[e]; }
            __builtin_nontemporal_store(y0, (f32x4*)(a.out + (size_t)m * DM + col)); __builtin_nontemporal_store(y1, (f32x4*)(a.out + (size_t)m * DM + col + 4)); }
    }
}

#define PH_IDS() const int tid = opaque_tid(), lane = tid & 63, wave = __builtin_amdgcn_readfirstlane(tid >> 6); (void)lane; (void)wave
__global__ void __launch_bounds__(512) fwd_megakernel(KArgs a) {
    unsigned char* lds = g_lds;
    cg::grid_group grid = cg::this_grid();
    unsigned char* ws = a.ws;
    PG8_LAS unsigned char* ldsa = (PG8_LAS unsigned char*)lds;
    const int G = gridDim.x, c = blockIdx.x;
    bf16_t* P = (bf16_t*)(ws + WS_BIG);
    volatile PG8_LAS unsigned* bst = (volatile PG8_LAS unsigned*)(ldsa + (LDS_BYTES - 16));
    if (threadIdx.x < 4) bst[threadIdx.x] = 0u;
    if (threadIdx.x == 0) {
#pragma unroll
        for (int k = 0; k < 37; ++k) *(unsigned long long*)(g_lds + PTAB_OFF + 8 * k) = (unsigned long long)a.in[k]; }
    __syncthreads();
    const XcdBarrier xbar = xcd_barrier_post((unsigned*)(ws + WS_BAR), bst);
    if (a.ws == nullptr) grid.sync();

#if !defined(ONLY) || ONLY == 0
    { PH_IDS(); phase0(a, lds, tid, wave, lane); }
#endif
    xcd_barrier(xbar);
#if !defined(ONLY) || ONLY == 1
    { pg8::Gemm g{(const bf16_t*)(ws + WS_XN), (const bf16_t*)(ws + WS_WT_IN), NTOK, PIN, DM}; pg8::StaticOrder S; S.init(NTOK, PIN, G, c);
      EpiB16 E{P, PIN, C_GATE / 256}; pg8::gemm_phase<EpiB16, pg8::StaticOrder>(ldsa, g, S, E, nullptr); }
    { pg8::Gemm g{(const bf16_t*)(ws + WS_MEMN), (const bf16_t*)(ws + WS_WT_MEMKV), 1024, 1024, DM}; pg8::StaticOrder S; S.init(1024, 1024, G, (c + G - 196) % G);
      EpiMemKV E{a.out + O_MEMK_P, a.out + O_MEMV_P, (bf16_t*)(ws + WS_MEMKV)}; pg8::gemm_phase<EpiMemKV, pg8::StaticOrder>(ldsa, g, S, E, nullptr); }
#endif
    xcd_barrier(xbar);
#if !defined(ONLY) || ONLY == 2
    { PH_IDS(); phase2(a, lds, tid, wave, lane); }
#endif
    xcd_barrier(xbar);
#if !defined(ONLY) || ONLY == 3
    { pg8::Gemm g{(const bf16_t*)(ws + WS_ALR), (const bf16_t*)(ws + WS_WT_LR), NTOK, 2304, 256}; pg8::StaticOrder S; S.init(NTOK, 2304, G, c);
      EpiB16 E{(bf16_t*)(ws + WS_LRO), 2304, 1 << 30}; pg8::gemm_phase<EpiB16, pg8::StaticOrder>(ldsa, g, S, E, nullptr); }
#endif
    xcd_barrier(xbar);
#if !defined(ONLY) || ONLY == 4
    { PH_IDS(); phase3b(a, wave, lane); }
    xcd_barrier(xbar);
    { PH_IDS(); phase4(a, lds, tid, wave, lane); }
#endif
    xcd_barrier(xbar);
#if !defined(ONLY) || ONLY == 5
    { PH_IDS(); phase5(a, wave, lane); }
#endif
    xcd_barrier(xbar);
#if !defined(ONLY) || ONLY == 6
    { pg8::StaticOrder S; S.init(8192, DM, G, c);
      { pg8::Gemm g{(const bf16_t*)(ws + WS_ORW), (const bf16_t*)(ws + WS_WT_BR0), NTOK, DM, 768}; EpiBr<0> E{(float*)(ws + WS_MRG), nullptr, P + C_GATE}; pg8::gemm_phase<EpiBr<0>, pg8::StaticOrder>(ldsa, g, S, E, nullptr); }
      { pg8::Gemm g{(const bf16_t*)(ws + WS_OSW), (const bf16_t*)(ws + WS_WT_BR1), NTOK, DM, 768}; EpiBr<1> E{(float*)(ws + WS_MRG), nullptr, P + C_GATE + DM}; pg8::gemm_phase<EpiBr<1>, pg8::StaticOrder>(ldsa, g, S, E, nullptr); }
      { pg8::Gemm g{(const bf16_t*)(ws + WS_OMEM), (const bf16_t*)(ws + WS_WT_BR2), NTOK, DM, 512}; EpiBr<2> E{(float*)(ws + WS_MRG), (bf16_t*)(ws + WS_MERGEDB), P + C_GATE + 2 * DM}; pg8::gemm_phase<EpiBr<2>, pg8::StaticOrder>(ldsa, g, S, E, nullptr); } }
    { const BrSplit S0{c, 0}, S1{c, 1}, S2{c, 2};
      { pg8::Gemm g{(const bf16_t*)(ws + WS_ORW), (const bf16_t*)(ws + WS_WT_BR0), NTOK, DM, 768}; EpiBrS E{(float*)(ws + WS_SLB), P + C_GATE}; pg8::gemm_phase<EpiBrS, BrSplit>(ldsa, g, S0, E, nullptr); }
      { pg8::Gemm g{(const bf16_t*)(ws + WS_OSW), (const bf16_t*)(ws + WS_WT_BR1), NTOK, DM, 768}; EpiBrS E{(float*)(ws + WS_SLB), P + C_GATE + DM}; pg8::gemm_phase<EpiBrS, BrSplit>(ldsa, g, S1, E, nullptr); }
      { pg8::Gemm g{(const bf16_t*)(ws + WS_OMEM), (const bf16_t*)(ws + WS_WT_BR2), NTOK, DM, 512}; EpiBrS E{(float*)(ws + WS_SLB), P + C_GATE + 2 * DM}; pg8::gemm_phase<EpiBrS, BrSplit>(ldsa, g, S2, E, nullptr); } }
    xcd_barrier(xbar);
    { PH_IDS(); const float* SLB = (const float*)(ws + WS_SLB); bf16_t* MB = (bf16_t*)(ws + WS_MERGEDB);
      for (int it = blockIdx.x * 512 + tid; it < 1024 * DM / 8; it += gridDim.x * 512) { const float* p = SLB + (size_t)it * 8; f32x4 t0 = *(const f32x4*)p, t1 = *(const f32x4*)(p + 4);
#pragma unroll
          for (int ks = 1; ks < 8; ++ks) { t0 += *(const f32x4*)(p + (size_t)ks * 1024 * DM); t1 += *(const f32x4*)(p + (size_t)ks * 1024 * DM + 4); }
          u32x4 w; w.x = cvt_pk_bf16(t0[0], t0[1]); w.y = cvt_pk_bf16(t0[2], t0[3]); w.z = cvt_pk_bf16(t1[0], t1[1]); w.w = cvt_pk_bf16(t1[2], t1[3]);
          *(u32x4*)(MB + (size_t)NPT * DM + (size_t)it * 8) = w; } }
    xcd_barrier(xbar);
    { pg8::Gemm g{(const bf16_t*)(ws + WS_MERGEDB), (const bf16_t*)(ws + WS_WT_O), NTOK, DM, DM}; RemOrder S; S.init(G, c, DM);
      EpiB16S E{(bf16_t*)(ws + WS_MRG), (float*)(ws + WS_SLAB)}; pg8::gemm_phase<EpiB16S, RemOrder>(ldsa, g, S, E, nullptr); }
#endif
    xcd_barrier(xbar);
#if !defined(ONLY) || ONLY == 8
    { PH_IDS(); phase8(a, wave, lane); }
#endif
    xcd_barrier(xbar);
#if !defined(ONLY) || ONLY == 9
    { pg8::Gemm g{(const bf16_t*)(ws + WS_XN), (const bf16_t*)(ws + WS_WT_UP), NTOK, 2 * DFF, DM}; UpOrder S; S.init(G, c);
      EpiZ E{P, (float*)(ws + WS_SLU)}; pg8::gemm_phase<EpiZ, UpOrder>(ldsa, g, S, E, nullptr); }
#endif
    xcd_barrier(xbar);
#if !defined(ONLY) || ONLY == 10
    { PH_IDS(); phase10(a, tid); }
#endif
    xcd_barrier(xbar);
#if !defined(ONLY) || ONLY == 11
    { pg8::Gemm g{(const bf16_t*)(ws + WS_ACT), (const bf16_t*)(ws + WS_WT_DN), NTOK, DM, DFF}; RemOrder S; S.init(G, c, DFF);
      EpiB16S E{(bf16_t*)(ws + WS_MRG), (float*)(ws + WS_SLAB)}; pg8::gemm_phase<EpiB16S, RemOrder>(ldsa, g, S, E, nullptr); }
#endif
    xcd_barrier(xbar);
#if !defined(ONLY) || ONLY == 12
    { PH_IDS(); phase12(a, wave, lane); }
#endif

}

extern "C" void kernel_launch(void* const* d_in, const int* in_sizes, int n_in, void* d_out, int out_size, void* d_ws, size_t ws_size, hipStream_t stream) {
    static int grid_blocks = 0;
    if (grid_blocks == 0) {
        if (n_in != 37 || (size_t)out_size != O_END || ws_size < WS_TOTAL) { fprintf(stderr, "kernel_launch: unexpected problem (n_in %d out %d ws %zu need %zu)\n", n_in, out_size, ws_size, (size_t)WS_TOTAL); grid_blocks = -1; return; }
        if (hipFuncSetAttribute((const void*)fwd_megakernel, hipFuncAttributeMaxDynamicSharedMemorySize, LDS_BYTES) != hipSuccess) { fprintf(stderr, "kernel_launch: hipFuncSetAttribute failed\n"); grid_blocks = -1; return; }
        int dev = 0, cus = 0, per_cu = 0;
        (void)hipGetDevice(&dev); (void)hipDeviceGetAttribute(&cus, hipDeviceAttributeMultiprocessorCount, dev);
        (void)hipOccupancyMaxActiveBlocksPerMultiprocessor(&per_cu, (const void*)fwd_megakernel, 512, LDS_BYTES);
        (void)hipGetLastError();
        if (cus < 256 || per_cu < 1) fprintf(stderr, "kernel_launch: note: cus %d per_cu %d\n", cus, per_cu);
        grid_blocks = 256;
    }
    if (grid_blocks < 0) return;
    if (hipMemsetAsync((char*)d_ws + WS_BAR, 0, XCD_BAR_WORDS * 4, stream) != hipSuccess) { fprintf(stderr, "kernel_launch: memset failed\n"); return; }
    KArgs a{};
    for (int i = 0; i < 37; ++i) a.in[i] = (const float*)d_in[i];
    a.out = (float*)d_out; a.ws = (unsigned char*)d_ws;
    void* args[] = {&a};
    hipError_t e = hipLaunchCooperativeKernel((const void*)fwd_megakernel, dim3(grid_blocks), dim3(512), args, LDS_BYTES, stream);
    if (e != hipSuccess) fprintf(stderr, "cooperative launch failed: %s (grid %d)\n", hipGetErrorString(e), grid_blocks);
}
```

```cpp
#include <hip/hip_runtime.h>
#include <hip/hip_cooperative_groups.h>
#include <cstdio>
__device__ __forceinline__ int opaque_tid() { int t = threadIdx.x; asm volatile("" : "+v"(t)); return t; }
namespace pg8 {
#define PG8_LAS __attribute__((address_space(3)))
typedef unsigned short bf16_t;
typedef short bf16x8 __attribute__((ext_vector_type(8)));
typedef float f32x4 __attribute__((ext_vector_type(4)));
typedef unsigned u32x4 __attribute__((ext_vector_type(4)));
constexpr int BM = 256, BK = 64, HALF = 128, HTB = HALF * BK * 2  , STAGE_BYTES = 8 * HTB, NXCD = 8, WGM = 4;

__host__ __device__ __forceinline__ int lds_byte(int r, int c) { const int st = (r >> 4) * 2 + (c >> 5), rr = r & 15, cc = c & 31, ob = rr * 64 + cc * 2; return st * 1024 + (ob ^ (((ob >> 9) & 1) << 5)); }
__host__ __device__ __forceinline__ void stage_rc(int b, int& R, int& C) { const int st = b / 1024, sb = b % 1024, swz = sb ^ (((sb >> 9) & 1) << 5); R = (st >> 1) * 16 + swz / 64; C = (st & 1) * 32 + (swz % 64) / 2; }
__host__ __device__ __forceinline__ int perm32(int rho) { const int n = rho >> 4, i = rho & 15; return 8 * (i >> 2) + 4 * n + (i & 3); }

struct Unit { int pm, pn, k0, nt, ks; };
struct Gemm { const bf16_t* A; const bf16_t* Bt; int M, N, K; };

struct StaticOrder {
    int nM, nN, nwg, G, c;
    __host__ __device__ void init(int M, int N, int G_, int c_) { nM = M / BM; nN = N / BM; nwg = nM * nN; G = G_; c = c_; }
    __host__ __device__ bool next(int i, Unit& u) const {
        const long L = (long)i * G + c; if (L >= nwg) return false;
        int wgid = (int)L; { const int q = nwg / NXCD, r = nwg % NXCD, xcd = wgid % NXCD, off = wgid / NXCD; wgid = (xcd < r ? xcd * (q + 1) : r * (q + 1) + (xcd - r) * q) + off; }
        const int nig = WGM * nN, gid = wgid / nig, fm = gid * WGM, gsz = (nM - fm) < WGM ? (nM - fm) : WGM;
        u.pm = fm + ((wgid % nig) % gsz); u.pn = (wgid % nig) / gsz; u.k0 = 0; u.nt = 0; u.ks = -1; return true;
    }
    __device__ __forceinline__ void a_ready(const Unit&) const {}
    __device__ __forceinline__ void done(const Unit&) const {}
};
__device__ __forceinline__ unsigned cvt_pk_bf16(float lo, float hi) { unsigned r; asm volatile("v_cvt_pk_bf16_f32 %0, %1, %2" : "=v"(r) : "v"(lo), "v"(hi)); return r; }
typedef float f32x2 __attribute__((ext_vector_type(2)));
template <class Epi, class Sched, bool STAMP = false>
__device__ __forceinline__ void gemm_phase(PG8_LAS unsigned char* lds, const Gemm g, const Sched& S, const Epi& E, unsigned long long* stamps) {
    const int tid = opaque_tid(), wid = __builtin_amdgcn_readfirstlane(tid >> 6), lane = tid & 63, wr = wid >> 2, wc = wid & 3, fr = lane & 15, fq = lane >> 4;
    const int K = g.K, ntf = K / BK;
    int ts_lo = 0, ts_hi = 0, nts = 0; const unsigned long long rt_entry = STAMP ? (unsigned long long)wall_clock64() : 0ull;
#define PG8_STAMP() do { if (STAMP && wid == 0 && nts < 64) { const unsigned long long _c = (unsigned long long)clock64(); \
        ts_lo = (lane == nts) ? (int)(unsigned)_c : ts_lo; ts_hi = (lane == nts) ? (int)(unsigned)(_c >> 32) : ts_hi; ++nts; } } while (0)
    PG8_STAMP();
    unsigned voffA[2], voffB[2];
#pragma unroll
    for (int i = 0; i < 2; ++i) { int R, C; stage_rc(tid * 16 + i * 8192, R, C); const int Rb = Epi::PERM ? ((R & ~31) + perm32(R & 31)) : R;
        voffA[i] = (unsigned)(R * K + C) * 2u; voffB[i] = (unsigned)(Rb * K + C) * 2u; }
    const size_t kstep = (size_t)(BK * 2);
    const size_t hstep = (size_t)HALF * K * 2;
    const size_t tstep = 2 * hstep;
    const unsigned ldsw = (unsigned)wid * 1024u;
    const int aoff = lds_byte(wr * 64 + fr, fq * 8), boff = lds_byte(wc * 32 + fr, fq * 8);
#define PG8_SA(b, h) (((b) * 2 + (h)) * HTB)
#define PG8_SB(b, h) ((4 + (b) * 2 + (h)) * HTB)
#define PG8_STAGE(bufoff, gbase, voff) do { _Pragma("unroll") for (int _i = 0; _i < 2; ++_i) \
        __builtin_amdgcn_global_load_lds((const unsigned*)((const char*)(gbase) + (voff)[_i]), (PG8_LAS unsigned*)(lds + (bufoff) + ldsw + _i * 8192), 16, 0, 0); } while (0)
#define PG8_LDA(dst, b, h) do { _Pragma("unroll") for (int m = 0; m < 4; ++m) _Pragma("unroll") for (int k = 0; k < 2; ++k) dst[m][k] = *(const PG8_LAS bf16x8*)(lds + PG8_SA(b, h) + aoff + m * 2048 + k * 1024); } while (0)
#define PG8_LDB(dst, b, h) do { _Pragma("unroll") for (int n = 0; n < 2; ++n) _Pragma("unroll") for (int k = 0; k < 2; ++k) dst[n][k] = *(const PG8_LAS bf16x8*)(lds + PG8_SB(b, h) + boff + n * 2048 + k * 1024); } while (0)
#define PG8_MMA(ai, bj, At, Bt) do { __builtin_amdgcn_s_setprio(1); _Pragma("unroll") for (int m = 0; m < 4; ++m) _Pragma("unroll") for (int n = 0; n < 2; ++n) _Pragma("unroll") for (int k = 0; k < 2; ++k) \
        acc[ai][bj][m][n] = __builtin_amdgcn_mfma_f32_16x16x32_bf16(Bt[n][k], At[m][k], acc[ai][bj][m][n], 0, 0, 0); __builtin_amdgcn_s_setprio(0); } while (0)
#define PG8_WAIT_V(n) asm volatile("s_waitcnt vmcnt(" #n ")" ::: "memory")
#define PG8_WAIT_L(n) asm volatile("s_waitcnt lgkmcnt(" #n ")" ::: "memory")
#define PG8_BAR __builtin_amdgcn_s_barrier()
#define PG8_SCHED __builtin_amdgcn_sched_barrier(0)
    Unit cur, nxt; int ui = 0;
    if (!S.next(0, cur)) return;
    if (cur.nt == 0) cur.nt = ntf;
    f32x4 acc[2][2][4][2];
#pragma unroll
    for (int a = 0; a < 2; ++a)
#pragma unroll
        for (int b = 0; b < 2; ++b)
#pragma unroll
            for (int m = 0; m < 4; ++m)
#pragma unroll
                for (int n = 0; n < 2; ++n) acc[a][b][m][n] = (f32x4){0.f, 0.f, 0.f, 0.f};
    bf16x8 At[4][2], B0[2][2], B1[2][2];
    const char* cA = (const char*)g.A + (size_t)cur.pm * tstep + (size_t)cur.k0 * 2; const char* cB = (const char*)g.Bt + (size_t)cur.pn * tstep + (size_t)cur.k0 * 2;
    S.a_ready(cur);
    PG8_STAGE(PG8_SB(0, 0), cB, voffB); PG8_STAGE(PG8_SA(0, 0), cA, voffA); PG8_STAGE(PG8_SB(0, 1), cB + hstep, voffB); PG8_STAGE(PG8_SA(0, 1), cA + hstep, voffA);
    if (wr == 1) PG8_BAR;
    PG8_WAIT_V(4); PG8_BAR;
    PG8_STAGE(PG8_SB(1, 0), cB + kstep, voffB); PG8_STAGE(PG8_SA(1, 0), cA + kstep, voffA); PG8_STAGE(PG8_SB(1, 1), cB + hstep + kstep, voffB);
    PG8_WAIT_V(6); PG8_BAR;
    PG8_STAMP();
    for (;;) {
        const bool has_next = S.next(ui + 1, nxt);
        if (has_next && nxt.nt == 0) nxt.nt = ntf;
        const int nt = cur.nt;
        const char* nA = has_next ? (const char*)g.A + (size_t)nxt.pm * tstep + (size_t)nxt.k0 * 2 : cA; const char* nB = has_next ? (const char*)g.Bt + (size_t)nxt.pn * tstep + (size_t)nxt.k0 * 2 : cB;
        for (int t = 0; t < nt; t += 2) {
            const bool last = (t == nt - 2);
            const char* a1 = cA + (size_t)(t + 1) * kstep;
            const char* a2 = last ? nA : cA + (size_t)(t + 2) * kstep; const char* b2 = last ? nB : cB + (size_t)(t + 2) * kstep;
            const char* a3 = a2 + kstep; const char* b3 = b2 + kstep;
            if (last && has_next) S.a_ready(nxt);
            PG8_LDB(B0, 0, 0); PG8_SCHED; PG8_LDA(At, 0, 0); PG8_STAGE(PG8_SA(1, 1), a1 + hstep, voffA);
            PG8_WAIT_L(8); PG8_BAR; PG8_WAIT_L(0); PG8_MMA(0, 0, At, B0); PG8_BAR; PG8_SCHED;
            PG8_LDB(B1, 0, 1); PG8_STAGE(PG8_SB(0, 0), b2, voffB);
            PG8_BAR; PG8_WAIT_L(0); PG8_MMA(0, 1, At, B1); PG8_BAR;
            PG8_LDA(At, 0, 1); PG8_STAGE(PG8_SA(0, 0), a2, voffA);
            PG8_BAR; PG8_WAIT_L(0); PG8_MMA(1, 0, At, B0); PG8_BAR; PG8_SCHED;
            PG8_STAGE(PG8_SB(0, 1), b2 + hstep, voffB);
            PG8_WAIT_V(6); PG8_BAR; PG8_MMA(1, 1, At, B1); PG8_BAR;
            PG8_LDB(B0, 1, 0); PG8_SCHED; PG8_LDA(At, 1, 0); PG8_STAGE(PG8_SA(0, 1), a2 + hstep, voffA);
            PG8_WAIT_L(8); PG8_BAR; PG8_WAIT_L(0); PG8_MMA(0, 0, At, B0); PG8_BAR; PG8_SCHED;
            PG8_LDB(B1, 1, 1); PG8_STAGE(PG8_SB(1, 0), b3, voffB);
            PG8_BAR; PG8_WAIT_L(0); PG8_MMA(0, 1, At, B1); PG8_BAR;
            PG8_LDA(At, 1, 1); PG8_STAGE(PG8_SA(1, 0), a3, voffA);
            PG8_BAR; PG8_WAIT_L(0); PG8_MMA(1, 0, At, B0); PG8_BAR; PG8_SCHED;
            PG8_STAGE(PG8_SB(1, 1), b3 + hstep, voffB);
            PG8_WAIT_V(6); PG8_BAR; PG8_MMA(1, 1, At, B1); PG8_BAR;
        }
        PG8_STAMP();
        if constexpr (!Epi::AFTER_DRAIN) { E(acc, cur, wr, wc, fr, fq); S.done(cur); }
        PG8_STAMP();
        if (!has_next) break;
#pragma unroll
        for (int a = 0; a < 2; ++a)
#pragma unroll
            for (int b = 0; b < 2; ++b)
#pragma unroll
                for (int m = 0; m < 4; ++m)
#pragma unroll
                    for (int n = 0; n < 2; ++n) acc[a][b][m][n] = (f32x4){0.f, 0.f, 0.f, 0.f};
        cur = nxt; cA = nA; cB = nB; ++ui;
    }
    PG8_WAIT_V(0);
    if (wr == 0) PG8_BAR;
    PG8_BAR;
    if constexpr (Epi::AFTER_DRAIN) { E.fused(acc, cur, wr, wc, fr, fq, lds, wid, lane); S.done(cur); }
    PG8_STAMP();
    if (STAMP && wid == 0) { stamps[lane] = lane < nts ? (((unsigned long long)(unsigned)ts_hi << 32) | (unsigned)ts_lo) : 0ull;
        if (lane == 62) stamps[62] = rt_entry; if (lane == 63) stamps[63] = (unsigned long long)wall_clock64(); }
#undef PG8_STAMP
#undef PG8_SA
#undef PG8_SB
#undef PG8_STAGE
#undef PG8_LDA
#undef PG8_LDB
#undef PG8_MMA
#undef PG8_WAIT_V
#undef PG8_WAIT_L
#undef PG8_BAR
#undef PG8_SCHED
}
}

namespace cg = cooperative_groups;
using pg8::bf16_t; using pg8::bf16x8; using pg8::f32x4; using pg8::u32x4; using pg8::cvt_pk_bf16;
typedef unsigned u32x2 __attribute__((ext_vector_type(2)));

constexpr int DM = 2048, NTOK = 9216, NPT = 8192, SEQ = 2048, PIN = 10496, RWW = 768, RWP = 2560, DFF = 5632;
constexpr int C_QSW = 2560, C_KSW = 3328, C_VSW = 3584, C_QMEM = 3840, C_GATE = 4352;
constexpr int LDS_BYTES = 147456;
constexpr float NEPS = 1e-6f;

constexpr size_t WS_WT_IN = 0;
constexpr size_t WS_WT_MEMKV = WS_WT_IN + (size_t)PIN * DM * 2;
constexpr size_t WS_WT_LR = WS_WT_MEMKV + (size_t)1024 * DM * 2;
constexpr size_t WS_WT_BR0 = WS_WT_LR + (size_t)2304 * 256 * 2;
constexpr size_t WS_WT_BR1 = WS_WT_BR0 + (size_t)DM * 768 * 2;
constexpr size_t WS_WT_BR2 = WS_WT_BR1 + (size_t)DM * 768 * 2;
constexpr size_t WS_WT_O = WS_WT_BR2 + (size_t)DM * 512 * 2;
constexpr size_t WS_XN = WS_WT_O + (size_t)DM * DM * 2;
constexpr size_t WS_MEMN = WS_XN + (size_t)NTOK * DM * 2;
constexpr size_t WS_MEMKV = WS_MEMN + (size_t)1024 * DM * 2;
constexpr size_t WS_ALR = WS_MEMKV + (size_t)1024 * 1024 * 2;
constexpr size_t WS_WT_UP = WS_ALR + (size_t)NTOK * 256 * 2;
constexpr size_t WS_WT_DN = WS_WT_UP + (size_t)2 * DFF * DM * 2;
constexpr size_t WS_BIG = WS_WT_DN + (size_t)DM * DFF * 2;
constexpr size_t WS_H = WS_BIG + (size_t)NTOK * 2 * DFF * 2;
constexpr size_t WS_MRG = WS_H + (size_t)NTOK * DM * 4;
constexpr size_t WS_END = WS_MRG + (size_t)NTOK * DM * 4;
constexpr size_t WS_BAR = WS_END;
constexpr size_t WS_TOTAL = WS_BAR + 16384;
constexpr size_t WS_SLAB = WS_BIG;
constexpr size_t WS_SLU = WS_MRG;
constexpr size_t WS_SLB = WS_H;
constexpr size_t WS_ACT = 0;
constexpr size_t WS_ORW = WS_WT_IN;
constexpr size_t WS_OSW = WS_ORW + (size_t)NTOK * 768 * 2;
constexpr size_t WS_OMEM = WS_OSW + (size_t)NTOK * 768 * 2;
constexpr size_t WS_MERGEDB = WS_XN;
constexpr size_t WS_LRO = WS_H;
constexpr size_t WS_ORAW = WS_MRG;
constexpr size_t WS_BONUS = WS_ORAW + (size_t)NTOK * 768 * 4;
constexpr size_t PREP_E = (size_t)NPT * 12 * 64;
constexpr size_t WS_PB = WS_XN;
constexpr size_t WS_PKQ = WS_PB + PREP_E * 2;
constexpr size_t WS_PR = WS_PKQ + PREP_E * 2;
constexpr size_t WS_PW = WS_LRO + (size_t)NTOK * 2304 * 2;
constexpr size_t WS_PNK = WS_BONUS + (size_t)NTOK * 12 * 4;
constexpr size_t WS_PV = WS_PNK + PREP_E * 4;
static_assert(WS_PR + PREP_E * 2 <= WS_WT_UP, "prep alias 1");
static_assert(WS_PW + PREP_E * 4 <= WS_MRG, "prep alias 2");
static_assert(WS_PV + PREP_E * 2 <= WS_END, "prep alias 3");
static_assert(WS_ACT + (size_t)NTOK * DFF * 2 <= WS_WT_UP, "ACT alias");
static_assert(WS_OMEM + (size_t)NTOK * 512 * 2 <= WS_WT_MEMKV, "O alias");
static_assert(WS_BONUS + (size_t)NTOK * 12 * 4 <= WS_END, "bonus alias");

constexpr size_t O_Y = 0;
constexpr size_t O_SWAK_P = (size_t)NTOK * DM;
constexpr size_t O_SWAV_P = O_SWAK_P + 131072;
constexpr size_t O_MEMK_P = O_SWAV_P + 131072;
constexpr size_t O_MEMV_P = O_MEMK_P + 524288;
constexpr size_t O_SHIFT_P = O_MEMV_P + 524288;
constexpr size_t O_WKV_P = O_SHIFT_P + 10240;
constexpr size_t O_CONV_P = O_WKV_P + 196608;
constexpr size_t O_SWAK_S = O_CONV_P + 45056;
constexpr size_t O_SWAV_S = O_SWAK_S + 4194304;
constexpr size_t O_SHIFT_S = O_SWAV_S + 4194304;
constexpr size_t O_WKV_S = O_SHIFT_S + 327680;
constexpr size_t O_CONV_S = O_WKV_S + 6291456;
constexpr size_t O_END = O_CONV_S + 1441792;

struct KArgs { const float* in[37]; float* out; unsigned char* ws; };
extern __shared__ __attribute__((aligned(16))) unsigned char g_lds[];
constexpr int PTAB_OFF = LDS_BYTES - 16 - 40 * 8;
__device__ __forceinline__ const float* INP(int k) {
    const unsigned long long v = *(const unsigned long long*)(g_lds + PTAB_OFF + 8 * k);
    const unsigned lo = (unsigned)__builtin_amdgcn_readfirstlane((int)(unsigned)v), hi = (unsigned)__builtin_amdgcn_readfirstlane((int)(unsigned)(v >> 32));
    return (const float*)(((unsigned long long)hi << 32) | lo);
}

__device__ __forceinline__ float bflo(unsigned u) { return __uint_as_float(u << 16); }
__device__ __forceinline__ float bfhi(unsigned u) { return __uint_as_float(u & 0xffff0000u); }
__device__ __forceinline__ float bf2f(bf16_t b) { return __uint_as_float(((unsigned)b) << 16); }
__device__ __forceinline__ bf16_t f2bf(float f) { return (bf16_t)(cvt_pk_bf16(f, 0.f) & 0xffffu); }
__device__ __forceinline__ float sigmoidf_(float v) { return __builtin_amdgcn_rcpf(1.f + __expf(-v)); }
#define DPP_ADD(v, ctrl) v += __int_as_float(__builtin_amdgcn_update_dpp(0, __float_as_int(v), ctrl, 0xF, 0xF, false))
__device__ __forceinline__ float rowsum16(float v) { DPP_ADD(v, 0xB1); DPP_ADD(v, 0x4E); DPP_ADD(v, 0x141); DPP_ADD(v, 0x140); return v; }
__device__ __forceinline__ float wave_sum(float v) { v = rowsum16(v); const int iv = __float_as_int(v);
    const float s0 = __int_as_float(__builtin_amdgcn_readlane(iv, 0)), s1 = __int_as_float(__builtin_amdgcn_readlane(iv, 16)), s2 = __int_as_float(__builtin_amdgcn_readlane(iv, 32)), s3 = __int_as_float(__builtin_amdgcn_readlane(iv, 48));
    return (s0 + s1) + (s2 + s3); }
__device__ __forceinline__ void lds_fence() { asm volatile("s_waitcnt lgkmcnt(0)" ::: "memory"); }

struct EpiF32 {
    static constexpr bool PERM = false, AFTER_DRAIN = false;
    float* C; int ldc;
    __device__ __forceinline__ void operator()(const f32x4 (&acc)[2][2][4][2], const pg8::Unit& u, int wr, int wc, int fr, int fq) const {
        const int row0 = u.pm * 256 + wr * 64 + fr, col0 = u.pn * 256 + wc * 32 + 4 * fq;
#pragma unroll
        for (int ai = 0; ai < 2; ++ai)
#pragma unroll
            for (int m = 0; m < 4; ++m) { float* rowp = C + (size_t)(row0 + ai * 128 + m * 16) * ldc + col0;
#pragma unroll
                for (int bj = 0; bj < 2; ++bj)
#pragma unroll
                    for (int n = 0; n < 2; ++n) *(f32x4*)(rowp + bj * 128 + n * 16) = acc[ai][bj][m][n]; }
    }
};
struct EpiB16 {
    static constexpr bool PERM = true, AFTER_DRAIN = false;
    bf16_t* O; int ldc; int sig_pn;
    __device__ __forceinline__ void operator()(const f32x4 (&acc)[2][2][4][2], const pg8::Unit& u, int wr, int wc, int fr, int fq) const {
        const int row0 = u.pm * 256 + wr * 64 + fr, col0 = u.pn * 256 + wc * 32 + 8 * fq;
        const bool sig = u.pn >= sig_pn;
#pragma unroll
        for (int ai = 0; ai < 2; ++ai)
#pragma unroll
            for (int m = 0; m < 4; ++m) { bf16_t* rowp = O + (size_t)(row0 + ai * 128 + m * 16) * ldc + col0;
#pragma unroll
                for (int bj = 0; bj < 2; ++bj) { f32x4 v0 = acc[ai][bj][m][0], v1 = acc[ai][bj][m][1];
                    if (sig) {
#pragma unroll
                        for (int j = 0; j < 4; ++j) { v0[j] = sigmoidf_(v0[j]); v1[j] = sigmoidf_(v1[j]); } }
                    u32x4 w; w.x = cvt_pk_bf16(v0[0], v0[1]); w.y = cvt_pk_bf16(v0[2], v0[3]); w.z = cvt_pk_bf16(v1[0], v1[1]); w.w = cvt_pk_bf16(v1[2], v1[3]);
                    if (sig) __builtin_nontemporal_store(w, (u32x4*)(rowp + bj * 128)); else *(u32x4*)(rowp + bj * 128) = w; } }
    }
};
struct EpiMemKV {
    static constexpr bool PERM = true, AFTER_DRAIN = false;
    float* OK; float* OV; bf16_t* B;
    __device__ __forceinline__ void operator()(const f32x4 (&acc)[2][2][4][2], const pg8::Unit& u, int wr, int wc, int fr, int fq) const {
        const int row0 = u.pm * 256 + wr * 64 + fr, col0 = u.pn * 256 + wc * 32 + 8 * fq;
        float* F = (u.pn >= 2) ? OV : OK; const int fcol0 = col0 & 511;
#pragma unroll
        for (int ai = 0; ai < 2; ++ai)
#pragma unroll
            for (int m = 0; m < 4; ++m) { const int row = row0 + ai * 128 + m * 16;
#pragma unroll
                for (int bj = 0; bj < 2; ++bj) { const f32x4 v0 = acc[ai][bj][m][0], v1 = acc[ai][bj][m][1];
                    *(f32x4*)(F + (size_t)row * 512 + fcol0 + bj * 128) = v0; *(f32x4*)(F + (size_t)row * 512 + fcol0 + bj * 128 + 4) = v1;
                    u32x4 w; w.x = cvt_pk_bf16(v0[0], v0[1]); w.y = cvt_pk_bf16(v0[2], v0[3]); w.z = cvt_pk_bf16(v1[0], v1[1]); w.w = cvt_pk_bf16(v1[2], v1[3]);
                    *(u32x4*)(B + (size_t)row * 1024 + col0 + bj * 128) = w; } }
    }
};
template <int MODE> struct EpiBr {
    static constexpr bool PERM = false, AFTER_DRAIN = false;
    float* MG; bf16_t* MB; const bf16_t* GATE;
    __device__ __forceinline__ void operator()(const f32x4 (&acc)[2][2][4][2], const pg8::Unit& u, int wr, int wc, int fr, int fq) const {
        const int row0 = u.pm * 256 + wr * 64 + fr, col0 = u.pn * 256 + wc * 32 + 4 * fq;
#pragma unroll
        for (int ai = 0; ai < 2; ++ai)
#pragma unroll
            for (int m = 0; m < 4; ++m) { const size_t row = (size_t)(row0 + ai * 128 + m * 16);
#pragma unroll
                for (int bj = 0; bj < 2; ++bj)
#pragma unroll
                    for (int n = 0; n < 2; ++n) { const int c = col0 + bj * 128 + n * 16;
                        const u32x2 gw = *(const u32x2*)(GATE + row * PIN + c);
                        f32x4 v = acc[ai][bj][m][n]; v[0] *= bflo(gw.x); v[1] *= bfhi(gw.x); v[2] *= bflo(gw.y); v[3] *= bfhi(gw.y);
                        if (MODE >= 1) v += *(const f32x4*)(MG + row * DM + c);
                        if (MODE <= 1) *(f32x4*)(MG + row * DM + c) = v;
                        else { u32x2 w; w.x = cvt_pk_bf16(v[0], v[1]); w.y = cvt_pk_bf16(v[2], v[3]); *(u32x2*)(MB + row * DM + c) = w; } } }
    }
};


#define XB_TMO      128
#define XB_XCNT(j)  (256  + 64 * (j))
#define XB_XSUB(j)  (1280 + 64 * (j))
#define XB_XGEN(j)  (2304 + 64 * (j))
#define XB_TOP      3328
#define XB_TOPGEN   3392
#define XCD_BAR_WORDS 3456
#define XB_SPIN_CAP (1u << 18)
__device__ __forceinline__ unsigned xb_ld(unsigned* p)              { return __hip_atomic_load(p, __ATOMIC_RELAXED, __HIP_MEMORY_SCOPE_AGENT); }
__device__ __forceinline__ unsigned xb_add(unsigned* p, unsigned v) { return __hip_atomic_fetch_add(p, v, __ATOMIC_RELAXED, __HIP_MEMORY_SCOPE_AGENT); }
__device__ __forceinline__ unsigned xb_xcc_id() { return (unsigned)__builtin_amdgcn_s_getreg((3 << 11) | 20) & 0xFu; }
#define XB_SPIN(cond, bar) do { unsigned _sp = 0; while (cond) { __builtin_amdgcn_s_sleep(1); \
    if ((++_sp & 255u) == 0u) { if (xb_ld(&(bar)[XB_TMO])) break; if (_sp > XB_SPIN_CAP) { atomicAdd(&(bar)[XB_TMO], 1u); break; } } } } while (0)
struct XcdBarrier { unsigned* bar; unsigned x; volatile PG8_LAS unsigned* st; };
__device__ __forceinline__ XcdBarrier xcd_barrier_post(unsigned* bar, volatile PG8_LAS unsigned* st) {
    XcdBarrier b; b.bar = bar; b.x = xb_xcc_id(); b.st = st;
    if (threadIdx.x == 0) (void)xb_add(&bar[XB_XCNT(b.x)], 1u);
    return b;
}
__device__ __forceinline__ void xcd_barrier_complete(unsigned* bar, unsigned x, unsigned& nloc, unsigned& nx) {
    const unsigned G = gridDim.x * gridDim.y * gridDim.z;
    unsigned sum, cnt, mine, sp = 0u;
    for (;;) {
        sum = 0u; cnt = 0u; mine = 0u;
#pragma unroll
        for (unsigned j = 0; j < 16; ++j) { const unsigned c = xb_ld(&bar[XB_XCNT(j)]); sum += c; cnt += (c > 0u) ? 1u : 0u; mine = (j == x) ? c : mine; }
        if (sum == G) break;
        __builtin_amdgcn_s_sleep(1);
        if ((++sp & 255u) == 0u) { if (xb_ld(&bar[XB_TMO])) break; if (sp > XB_SPIN_CAP) { atomicAdd(&bar[XB_TMO], 1u); break; } }
    }
    nloc = mine > 0u ? mine : 1u; nx = cnt > 0u ? cnt : 1u;
}
__device__ __forceinline__ void xcd_barrier(const XcdBarrier& b) {
    asm volatile("s_waitcnt vmcnt(0)" ::: "memory");
    __syncthreads();
    if (threadIdx.x == 0) {
        unsigned* bar = b.bar;
        __builtin_amdgcn_s_waitcnt(0);
        unsigned nloc = b.st[0], nx = b.st[1];
        if (nloc == 0u) { xcd_barrier_complete(bar, b.x, nloc, nx); b.st[0] = nloc; b.st[1] = nx; }
        const unsigned old = xb_add(&bar[XB_XSUB(b.x)], 1u);
        const unsigned gen = old / nloc;
        if (old + 1u == (gen + 1u) * nloc) {
            __builtin_amdgcn_fence(__ATOMIC_RELEASE, "agent");
            asm volatile("s_waitcnt vmcnt(0)" ::: "memory");
            const unsigned og = xb_add(&bar[XB_TOP], 1u);
            const unsigned tg = og / nx;
            if (og + 1u == (tg + 1u) * nx) xb_add(&bar[XB_TOPGEN], 1u);
            else XB_SPIN(xb_ld(&bar[XB_TOPGEN]) == tg, bar);
            __builtin_amdgcn_fence(__ATOMIC_ACQUIRE, "agent");
            xb_add(&bar[XB_XGEN(b.x)], 1u);
            asm volatile("s_waitcnt vmcnt(0)" ::: "memory");
        } else {
            XB_SPIN(xb_ld(&bar[XB_XGEN(b.x)]) == gen, bar);
            __builtin_amdgcn_fence(__ATOMIC_ACQUIRE, "agent");
            asm volatile("s_waitcnt vmcnt(0)" ::: "memory");
        }
    }
    __syncthreads();
}
struct RemOrder {
    pg8::StaticOrder so; int c, kblocks;
    __device__ void init(int G, int c_, int K) { so.init(8192, 2048, G, c_); c = c_; kblocks = K / 128; }
    __device__ bool next(int i, pg8::Unit& u) const {
        if (i == 0) return so.next(0, u);
        if (i == 1) { const int ks = c & 7, base = kblocks >> 3, rem = kblocks & 7; u.pm = 32 + (c >> 6); u.pn = (c >> 3) & 7;
            const int start = ks * base + (ks < rem ? ks : rem), cnt = base + (ks < rem ? 1 : 0); u.k0 = start * 128; u.nt = cnt * 2; u.ks = ks; return true; }
        return false;
    }
    __device__ __forceinline__ void a_ready(const pg8::Unit&) const {}
    __device__ __forceinline__ void done(const pg8::Unit&) const {}
};
struct EpiB16S {
    static constexpr bool PERM = true, AFTER_DRAIN = false;
    bf16_t* C; float* SLAB;
    __device__ __forceinline__ void operator()(const f32x4 (&acc)[2][2][4][2], const pg8::Unit& u, int wr, int wc, int fr, int fq) const {
        const int row0 = u.pm * 256 + wr * 64 + fr, col0 = u.pn * 256 + wc * 32 + 8 * fq;
        if (u.ks < 0) {
#pragma unroll
            for (int ai = 0; ai < 2; ++ai)
#pragma unroll
                for (int m = 0; m < 4; ++m) { bf16_t* rowp = C + (size_t)(row0 + ai * 128 + m * 16) * DM + col0;
#pragma unroll
                    for (int bj = 0; bj < 2; ++bj) { const f32x4 v0 = acc[ai][bj][m][0], v1 = acc[ai][bj][m][1];
                        u32x4 w; w.x = cvt_pk_bf16(v0[0], v0[1]); w.y = cvt_pk_bf16(v0[2], v0[3]); w.z = cvt_pk_bf16(v1[0], v1[1]); w.w = cvt_pk_bf16(v1[2], v1[3]);
                        *(u32x4*)(rowp + bj * 128) = w; } }
        } else {
            float* base = SLAB + ((size_t)u.ks * 1024 + (row0 - 8192)) * DM + col0;
#pragma unroll
            for (int ai = 0; ai < 2; ++ai)
#pragma unroll
                for (int m = 0; m < 4; ++m) { float* rowp = base + (size_t)(ai * 128 + m * 16) * DM;
#pragma unroll
                    for (int bj = 0; bj < 2; ++bj) { *(f32x4*)(rowp + bj * 128) = acc[ai][bj][m][0]; *(f32x4*)(rowp + bj * 128 + 4) = acc[ai][bj][m][1]; } }
        }
    }
};
struct UpOrder {
    pg8::StaticOrder so; int c;
    __device__ void init(int G, int c_) { so.init(8704, 2 * DFF, G, c_); c = c_; }
    __device__ bool next(int i, pg8::Unit& u) const {
        const int L = i * 256 + c;
        if (L < 1496) return so.next(i, u);
        if (L < 1536) { u.pm = 34; u.pn = L - 1496; u.k0 = 0; u.nt = 0; u.ks = -1; return true; }
        const int j = L - 1536; if (j >= 192) return false;
        const int ti = j >> 2, ks = j & 3; if (ti < 44) { u.pm = 35; u.pn = ti; } else { u.pm = 34; u.pn = ti - 4; }
        u.k0 = ks * 512; u.nt = 8; u.ks = ks; return true;
    }
    __device__ __forceinline__ void a_ready(const pg8::Unit&) const {}
    __device__ __forceinline__ void done(const pg8::Unit&) const {}
};
struct EpiZ {
    static constexpr bool PERM = true, AFTER_DRAIN = false;
    bf16_t* Z; float* SLU;
    __device__ __forceinline__ void operator()(const f32x4 (&acc)[2][2][4][2], const pg8::Unit& u, int wr, int wc, int fr, int fq) const {
        const int r0 = wr * 64 + fr, c0 = wc * 32 + 8 * fq;
        if (u.ks < 0) {
#pragma unroll
            for (int ai = 0; ai < 2; ++ai)
#pragma unroll
                for (int m = 0; m < 4; ++m) { bf16_t* rowp = Z + (size_t)(u.pm * 256 + r0 + ai * 128 + m * 16) * (2 * DFF) + u.pn * 256 + c0;
#pragma unroll
                    for (int bj = 0; bj < 2; ++bj) { const f32x4 v0 = acc[ai][bj][m][0], v1 = acc[ai][bj][m][1];
                        u32x4 w; w.x = cvt_pk_bf16(v0[0], v0[1]); w.y = cvt_pk_bf16(v0[2], v0[3]); w.z = cvt_pk_bf16(v1[0], v1[1]); w.w = cvt_pk_bf16(v1[2], v1[3]);
                        *(u32x4*)(rowp + bj * 128) = w; } }
        } else {
            const int ti = (u.pm == 35) ? u.pn : u.pn + 4;
            float* base = SLU + (((size_t)u.ks * 48 + ti) * 256 + r0) * 256 + c0;
#pragma unroll
            for (int ai = 0; ai < 2; ++ai)
#pragma unroll
                for (int m = 0; m < 4; ++m) { float* rowp = base + (size_t)(ai * 128 + m * 16) * 256;
#pragma unroll
                    for (int bj = 0; bj < 2; ++bj) { *(f32x4*)(rowp + bj * 128) = acc[ai][bj][m][0]; *(f32x4*)(rowp + bj * 128 + 4) = acc[ai][bj][m][1]; } }
        }
    }
};
struct BrSplit {
    int c, br;
    __device__ bool next(int i, pg8::Unit& u) const {
        if (i > 0) return false;
        const int s = c & 7, b = s < 3 ? 0 : (s < 6 ? 1 : 2); if (b != br) return false;
        const int ti = c >> 3; u.pm = 32 + (ti >> 3); u.pn = ti & 7; u.k0 = (b == 0 ? s : (b == 1 ? s - 3 : s - 6)) * 256; u.nt = 4; u.ks = s; return true;
    }
    __device__ __forceinline__ void a_ready(const pg8::Unit&) const {}
    __device__ __forceinline__ void done(const pg8::Unit&) const {}
};
struct EpiBrS {
    static constexpr bool PERM = false, AFTER_DRAIN = false;
    float* SLAB; const bf16_t* GATE;
    __device__ __forceinline__ void operator()(const f32x4 (&acc)[2][2][4][2], const pg8::Unit& u, int wr, int wc, int fr, int fq) const {
        const int row0 = u.pm * 256 + wr * 64 + fr, col0 = u.pn * 256 + wc * 32 + 4 * fq;
#pragma unroll
        for (int ai = 0; ai < 2; ++ai)
#pragma unroll
            for (int m = 0; m < 4; ++m) { const size_t row = (size_t)(row0 + ai * 128 + m * 16);
#pragma unroll
                for (int bj = 0; bj < 2; ++bj)
#pragma unroll
                    for (int n = 0; n < 2; ++n) { const int c = col0 + bj * 128 + n * 16;
                        const u32x2 gw = *(const u32x2*)(GATE + row * PIN + c);
                        f32x4 v = acc[ai][bj][m][n]; v[0] *= bflo(gw.x); v[1] *= bfhi(gw.x); v[2] *= bflo(gw.y); v[3] *= bfhi(gw.y);
                        *(f32x4*)(SLAB + ((size_t)u.ks * 1024 + (row - 8192)) * DM + c) = v; } }
    }
};
__device__ __forceinline__ void transpose_item(const float* __restrict__ W, int K, int N, bf16_t* __restrict__ WT, float* scr, int item, int lane) {
    const int nblk = N / 64, kb = item / nblk, nb = item - kb * nblk, k0 = 64 * kb, n0 = 64 * nb;
    f32x4 v[16];
#pragma unroll
    for (int i = 0; i < 16; ++i) v[i] = __builtin_nontemporal_load((const f32x4*)(W + (size_t)(k0 + 4 * i + (lane >> 4)) * N + n0 + (lane & 15) * 4));
#pragma unroll
    for (int i = 0; i < 16; ++i) { float* d = scr + (4 * i + (lane >> 4)) * 65 + (lane & 15) * 4; d[0] = v[i][0]; d[1] = v[i][1]; d[2] = v[i][2]; d[3] = v[i][3]; }
    lds_fence();
    const int c = lane & 7;
#pragma unroll
    for (int j = 0; j < 8; ++j) { const int n = (lane >> 3) + 8 * j; const float* s = scr + (8 * c) * 65 + n;
        u32x4 o; o.x = cvt_pk_bf16(s[0 * 65], s[1 * 65]); o.y = cvt_pk_bf16(s[2 * 65], s[3 * 65]); o.z = cvt_pk_bf16(s[4 * 65], s[5 * 65]); o.w = cvt_pk_bf16(s[6 * 65], s[7 * 65]);
        *(u32x4*)(WT + (size_t)(n0 + n) * K + k0 + 8 * c) = o; }
    lds_fence();
}
__device__ __forceinline__ void rms_row_to_bf16(const float* __restrict__ xrow, const float* __restrict__ g, bf16_t* __restrict__ orow, int lane) {
    const f32x4* xr = (const f32x4*)xrow + lane; const f32x4* gr = (const f32x4*)g + lane;
    f32x4 v[8]; float s = 0.f;
#pragma unroll
    for (int j = 0; j < 8; ++j) { v[j] = xr[64 * j]; s += (v[j][0] * v[j][0] + v[j][1] * v[j][1]) + (v[j][2] * v[j][2] + v[j][3] * v[j][3]); }
    const float rs = rsqrtf(wave_sum(s) * (1.f / DM) + NEPS);
    u32x2* o8 = (u32x2*)orow + lane;
#pragma unroll
    for (int j = 0; j < 8; ++j) { const f32x4 gg = gr[64 * j]; u32x2 w; w.x = cvt_pk_bf16(v[j][0] * rs * gg[0], v[j][1] * rs * gg[1]); w.y = cvt_pk_bf16(v[j][2] * rs * gg[2], v[j][3] * rs * gg[3]); o8[64 * j] = w; }
}
__device__ __forceinline__ const float* xrow_ptr(const KArgs& a, int tok) { return tok < NPT ? a.in[0] + (size_t)tok * DM : a.in[1] + (size_t)(tok - NPT) * DM; }

__device__ __forceinline__ void phase0(const KArgs& a, unsigned char* lds, int tid, int wave, int lane) {
    unsigned char* ws = a.ws;
    float* scr = (float*)(lds + wave * 16640);
    const int gw = blockIdx.x * 8 + wave, NGW = gridDim.x * 8;
    constexpr int I_IN = 32 * (PIN / 64), I_MKV = 32 * 16;
    constexpr int NITEMS = I_IN + I_MKV;
    for (int it = gw; it < NITEMS; it += NGW) {
        if (it < I_IN) transpose_item(a.in[11], DM, PIN, (bf16_t*)(ws + WS_WT_IN), scr, it, lane);
        else transpose_item(a.in[25], DM, 1024, (bf16_t*)(ws + WS_WT_MEMKV), scr, it - I_IN, lane);
    }
    { bf16_t* wl = (bf16_t*)(ws + WS_WT_LR);
      for (int i = blockIdx.x * 512 + tid; i < 2304 * 256; i += gridDim.x * 512) { const int n = i >> 8, k = i & 255; float v = 0.f;
          if (n < 768) { if (k < 64) v = a.in[13][k * 768 + n]; }
          else if (n < 1536) { if (k >= 64 && k < 128) v = a.in[15][(k - 64) * 768 + (n - 768)]; }
          else { if (k >= 128) v = a.in[17][(k - 128) * 768 + (n - 1536)]; }
          wl[i] = f2bf(v); } }
    for (int m = gw; m < NTOK + 1024; m += NGW) {
        if (m < NTOK) rms_row_to_bf16(xrow_ptr(a, m), a.in[10], (bf16_t*)(ws + WS_XN) + (size_t)m * DM, lane);
        else rms_row_to_bf16(a.in[9] + (size_t)(m - NTOK) * DM, a.in[24], (bf16_t*)(ws + WS_MEMN) + (size_t)(m - NTOK) * DM, lane);
    }
}

template <int D, int NKB>
__device__ __forceinline__ void attn_wave(const unsigned char* Ks, int kpitch, const unsigned char* VTs, int vpitch, int kb_lo,
                                          const bf16_t* qptr, float scale, int lo, int hi, float sink, bool use_sink, bf16_t* optr, bool store, int lane) {
    const int l15 = lane & 15, q4 = lane >> 4;
    const float NINF = -__builtin_inff();
    bf16x8 qf[D / 32];
#pragma unroll
    for (int ks = 0; ks < D / 32; ++ks) qf[ks] = *(const bf16x8*)(qptr + ks * 32 + q4 * 8);
    f32x4 s[NKB];
#pragma unroll
    for (int kb = 0; kb < NKB; ++kb) { f32x4 acc = (f32x4){0.f, 0.f, 0.f, 0.f};
#pragma unroll
        for (int ks = 0; ks < D / 32; ++ks) { const bf16x8 kf = *(const bf16x8*)(Ks + (size_t)((kb_lo + kb) * 16 + l15) * kpitch + (ks * 32 + q4 * 8) * 2);
            acc = __builtin_amdgcn_mfma_f32_16x16x32_bf16(kf, qf[ks], acc, 0, 0, 0); }
        s[kb] = acc; }
    float m = use_sink ? sink : NINF;
#pragma unroll
    for (int kb = 0; kb < NKB; ++kb)
#pragma unroll
        for (int r = 0; r < 4; ++r) { const int j = (kb_lo + kb) * 16 + q4 * 4 + r; float v = s[kb][r] * scale; v = (j >= lo && j <= hi) ? v : NINF; s[kb][r] = v; m = fmaxf(m, v); }
    m = fmaxf(m, __shfl_xor(m, 16)); m = fmaxf(m, __shfl_xor(m, 32));
    if (m == NINF) m = 0.f;
    float sum = 0.f;
#pragma unroll
    for (int kb = 0; kb < NKB; ++kb)
#pragma unroll
        for (int r = 0; r < 4; ++r) { const float e = __expf(s[kb][r] - m); s[kb][r] = e; sum += e; }
    sum += __shfl_xor(sum, 16); sum += __shfl_xor(sum, 32);
    if (use_sink) sum += __expf(sink - m);
    const float inv = 1.f / sum;
    f32x4 o[D / 16];
#pragma unroll
    for (int db = 0; db < D / 16; ++db) o[db] = (f32x4){0.f, 0.f, 0.f, 0.f};
#pragma unroll
    for (int pr = 0; pr < NKB / 2; ++pr) {
        u32x4 pw; pw.x = cvt_pk_bf16(s[2 * pr][0], s[2 * pr][1]); pw.y = cvt_pk_bf16(s[2 * pr][2], s[2 * pr][3]);
        pw.z = cvt_pk_bf16(s[2 * pr + 1][0], s[2 * pr + 1][1]); pw.w = cvt_pk_bf16(s[2 * pr + 1][2], s[2 * pr + 1][3]);
        const bf16x8 pf = __builtin_bit_cast(bf16x8, pw);
#pragma unroll
        for (int db = 0; db < D / 16; ++db) { const unsigned char* vp = VTs + (size_t)(db * 16 + l15) * vpitch + (db * 2 + (l15 >> 3)) * 8 + ((kb_lo + 2 * pr) * 16 + q4 * 4) * 2;
            const u32x2 v0 = *(const u32x2*)vp, v1 = *(const u32x2*)(vp + 32);
            u32x4 vw; vw.x = v0.x; vw.y = v0.y; vw.z = v1.x; vw.w = v1.y;
            o[db] = __builtin_amdgcn_mfma_f32_16x16x32_bf16(__builtin_bit_cast(bf16x8, vw), pf, o[db], 0, 0, 0); } }
    if (store) {
#pragma unroll
        for (int db = 0; db < D / 16; ++db) { u32x2 w; w.x = cvt_pk_bf16(o[db][0] * inv, o[db][1] * inv); w.y = cvt_pk_bf16(o[db][2] * inv, o[db][3] * inv);
            *(u32x2*)(optr + db * 16 + q4 * 4) = w; } }
}
__device__ __forceinline__ void vt_write8(unsigned char* VTs, int vpitch, int key, int d0, u32x4 w) {
    unsigned short* p = (unsigned short*)(VTs + (size_t)d0 * vpitch + (d0 >> 3) * 8 + key * 2); const int st = vpitch >> 1;
    p[0] = (unsigned short)(w.x & 0xffffu); p[st] = (unsigned short)(w.x >> 16); p[2 * st] = (unsigned short)(w.y & 0xffffu); p[3 * st] = (unsigned short)(w.y >> 16);
    p[4 * st] = (unsigned short)(w.z & 0xffffu); p[5 * st] = (unsigned short)(w.z >> 16); p[6 * st] = (unsigned short)(w.w & 0xffffu); p[7 * st] = (unsigned short)(w.w >> 16);
}
__device__ __forceinline__ u32x4 pack8(const f32x4 a, const f32x4 b) { u32x4 w; w.x = cvt_pk_bf16(a[0], a[1]); w.y = cvt_pk_bf16(a[2], a[3]); w.z = cvt_pk_bf16(b[0], b[1]); w.w = cvt_pk_bf16(b[2], b[3]); return w; }

constexpr int KP64 = 144, KP128 = 272, VTP = 544;
constexpr int VT_OFF64 = 256 * KP64, VT_OFF128 = 256 * KP128;

__device__ __forceinline__ void attn_mem_sample(const KArgs& a, unsigned char* lds, int u, int tid, int wave, int lane) {
    unsigned char* ws = a.ws; const bf16_t* P = (const bf16_t*)(ws + WS_BIG); bf16_t* OMEM = (bf16_t*)(ws + WS_OMEM);

        const int b = u >> 2, h = u & 3;
        unsigned char* Ks = lds; unsigned char* VTs = lds + VT_OFF128;
#pragma unroll
        for (int it = 0; it < 8; ++it) { const int ch = tid + it * 512, j = ch >> 4, c8 = ch & 15;
            const size_t off = ((size_t)(b * 256 + j) * 4 + h) * 128 + c8 * 8;
            const u32x4 kv = pack8(*(const f32x4*)(a.in[4] + off), *(const f32x4*)(a.in[4] + off + 4)), vv = pack8(*(const f32x4*)(a.in[5] + off), *(const f32x4*)(a.in[5] + off + 4));
            *(u32x4*)(Ks + j * KP128 + c8 * 16) = kv; vt_write8(VTs, VTP, j, c8 * 8, vv); }
        __syncthreads();
        if (wave == 0) { const int t = lane & 15, tc = t < 8 ? t : 7; const int tok = NPT + b * 8 + tc;
            attn_wave<128, 16>(Ks, KP128, VTs, VTP, 0, P + (size_t)tok * PIN + C_QMEM + h * 128, 0.08838834764831845f, 0, 255, 0.f, false, OMEM + (size_t)tok * 512 + h * 128, t < 8, lane); }
        __syncthreads();
    }
__device__ __forceinline__ void phase2(const KArgs& a, unsigned char* lds, int tid, int wave, int lane) {
    unsigned char* ws = a.ws;
    const bf16_t* P = (const bf16_t*)(ws + WS_BIG);
    bf16_t* OSW = (bf16_t*)(ws + WS_OSW); bf16_t* OMEM = (bf16_t*)(ws + WS_OMEM);
    const bf16_t* MEMKV = (const bf16_t*)(ws + WS_MEMKV);
    const float* sinks = a.in[23];
    const u32x4 zero4 = (u32x4){0u, 0u, 0u, 0u};
    unsigned char* Ks = lds;
    const int ua = blockIdx.x, ab = ua >> 6, akvh = (ua >> 4) & 3, aqb = ua & 15;
    { u32x4 rk[4], rv[4];
#pragma unroll
      for (int it = 0; it < 4; ++it) { const int ch = tid + it * 512, jj = ch >> 3, c8 = ch & 7; const int pos = aqb * 128 - 128 + jj; const bool ok = pos >= 0;
          const bf16_t* src = P + (size_t)(ab * SEQ + (ok ? pos : 0)) * PIN + akvh * 64 + c8 * 8; rk[it] = *(const u32x4*)(src + C_KSW); rv[it] = *(const u32x4*)(src + C_VSW); }
#pragma unroll
      for (int it = 0; it < 4; ++it) { const int ch = tid + it * 512, jj = ch >> 3, c8 = ch & 7; const bool ok = aqb * 128 - 128 + jj >= 0;
          *(u32x4*)(Ks + jj * KP64 + c8 * 16) = ok ? rk[it] : zero4; vt_write8(lds + VT_OFF64, VTP, jj, c8 * 8, ok ? rv[it] : zero4); } }
    __syncthreads();
    f32x4 bk0[3], bk1[3], bv0[3], bv1[3];
#define P2_LOAD_B(UB) do { const int b_ = (UB) >> 2, kvh_ = (UB) & 3; _Pragma("unroll") for (int it = 0; it < 3; ++it) { const int ch = tid + it * 512; const int jj = ch >> 3, c8 = ch & 7; \
        if (jj < 128) { const size_t off = ((size_t)(b_ * 128 + jj) * 4 + kvh_) * 64 + c8 * 8; bk0[it] = *(const f32x4*)(a.in[2] + off); bk1[it] = *(const f32x4*)(a.in[2] + off + 4); bv0[it] = *(const f32x4*)(a.in[3] + off); bv1[it] = *(const f32x4*)(a.in[3] + off + 4); } \
        else if (jj < 136) { const bf16_t* src = P + (size_t)(NPT + b_ * 8 + (jj - 128)) * PIN + kvh_ * 64 + c8 * 8; bk0[it] = *(const f32x4*)(src + C_KSW); bv0[it] = *(const f32x4*)(src + C_VSW); } } } while (0)
#define P2_STORE_B() do { _Pragma("unroll") for (int it = 0; it < 3; ++it) { const int ch = tid + it * 512; if (ch < 1280) { const int jj = ch >> 3, c8 = ch & 7; u32x4 kv = zero4, vv = zero4; \
        if (jj < 128) { kv = pack8(bk0[it], bk1[it]); vv = pack8(bv0[it], bv1[it]); } else if (jj < 136) { kv = __builtin_bit_cast(u32x4, bk0[it]); vv = __builtin_bit_cast(u32x4, bv0[it]); } \
        *(u32x4*)(Ks + jj * KP64 + c8 * 16) = kv; vt_write8(lds + VT_OFF64, VTP, jj, c8 * 8, vv); } } } while (0)
#define P2_COMPUTE_B(UB) do { if (wave < 3) { const int b_ = (UB) >> 2, kvh_ = (UB) & 3; const int t = lane & 15, tc = t < 8 ? t : 7; const int hq = kvh_ * 3 + wave; const int tok = NPT + b_ * 8 + tc; \
        attn_wave<64, 10>(Ks, KP64, lds + VT_OFF64, VTP, 0, P + (size_t)tok * PIN + C_QSW + hq * 64, 0.125f, tc + 1, tc + 128, sinks[hq], true, OSW + (size_t)tok * 768 + hq * 64, t < 8, lane); } } while (0)
    const int ub1 = blockIdx.x, ub2 = blockIdx.x + 256;
    P2_LOAD_B(ub1);
    {
      const int qi = wave * 16 + (lane & 15); const int tok = ab * SEQ + aqb * 128 + qi;
      const int lo = (aqb == 0) ? (qi + 1 > 128 ? qi + 1 : 128) : qi + 1, hi = qi + 128;
      const int kb_lo = wave < 6 ? wave : 6;
#pragma unroll 1
      for (int g = 0; g < 3; ++g) { const int hq = akvh * 3 + g;
          attn_wave<64, 10>(Ks, KP64, lds + VT_OFF64, VTP, kb_lo, P + (size_t)tok * PIN + C_QSW + hq * 64, 0.125f, lo, hi, sinks[hq], true, OSW + (size_t)tok * 768 + hq * 64, true, lane); } }
    __syncthreads();
    P2_STORE_B();
    __syncthreads();
    P2_LOAD_B(ub2);
    P2_COMPUTE_B(ub1);
    __syncthreads();
    P2_STORE_B();
    __syncthreads();
    const int uc = blockIdx.x, cb = uc >> 6, chh = (uc >> 4) & 3, cqb = uc & 15;
    u32x4 ck[8], cv[8];
#pragma unroll
    for (int it = 0; it < 8; ++it) { const int ch = tid + it * 512, jj = ch >> 4, c8 = ch & 15;
        const bf16_t* src = MEMKV + (size_t)(cb * 256 + jj) * 1024 + chh * 128 + c8 * 8; ck[it] = *(const u32x4*)src; cv[it] = *(const u32x4*)(src + 512); }
    P2_COMPUTE_B(ub2);
    __syncthreads();
#pragma unroll
    for (int it = 0; it < 8; ++it) { const int ch = tid + it * 512, jj = ch >> 4, c8 = ch & 15;
        *(u32x4*)(Ks + jj * KP128 + c8 * 16) = ck[it]; vt_write8(lds + VT_OFF128, VTP, jj, c8 * 8, cv[it]); }
    __syncthreads();
    { const int tok = cb * SEQ + cqb * 128 + wave * 16 + (lane & 15);
      attn_wave<128, 16>(Ks, KP128, lds + VT_OFF128, VTP, 0, P + (size_t)tok * PIN + C_QMEM + chh * 128, 0.08838834764831845f, 0, 255, 0.f, false, OMEM + (size_t)tok * 512 + chh * 128, true, lane); }
    __syncthreads();
#undef P2_LOAD_B
#undef P2_STORE_B
#undef P2_COMPUTE_B
    { bf16_t* ALR = (bf16_t*)(ws + WS_ALR); const float* mu = a.in[12];
      for (int i0 = blockIdx.x * 512 + tid; i0 < (NTOK / 8) * 256; i0 += gridDim.x * 512) { const int tq = i0 >> 8, c = i0 & 255, col = 2304 + c, tok0 = tq * 8;
          unsigned up[8]; float prev;
#pragma unroll
          for (int q = 0; q < 8; ++q) up[q] = P[(size_t)(tok0 + q) * PIN + col];
          if (tok0 < NPT) prev = (tok0 & (SEQ - 1)) ? bf2f(P[(size_t)(tok0 - 1) * PIN + col]) : 0.f;
          else { const int st = tok0 - NPT; prev = (st & 7) ? bf2f(P[(size_t)(tok0 - 1) * PIN + col]) : a.in[6][(size_t)(st >> 3) * RWP + col]; }
          const float m = mu[col];
#pragma unroll
          for (int q = 0; q < 8; ++q) { const float p = bflo(up[q]); const float s = p + m * (prev - p); prev = p;
              float v; if (c < 64) { const float e = __expf(2.f * s); v = 1.f - 2.f * __builtin_amdgcn_rcpf(e + 1.f); } else if (c < 128) v = s; else v = sigmoidf_(s);
              ALR[(size_t)(tok0 + q) * 256 + c] = f2bf(v); } } }
}

constexpr int TC = 32;
constexpr int SCAN_BUF_FLOATS = TC * 320 + TC * 16 + 1024;
constexpr int SCAN_OUT_OFF = 2 * SCAN_BUF_FLOATS * 4;
#define SCAN_BAR() asm volatile("s_waitcnt lgkmcnt(0)\n\ts_barrier" ::: "memory")

struct SUnit { int tok0, len, b, h, rb; bool first, last, prompt; };
__device__ __forceinline__ SUnit scan_unit(int blk, int u) {
    SUnit s;
    if (blk < 192) { const int bh = blk >> 2; s.b = bh / 12; s.h = bh - s.b * 12; s.rb = blk & 3; s.tok0 = s.b * SEQ + u * TC; s.len = TC; s.first = (u == 0); s.last = (u == SEQ / TC - 1); s.prompt = true; }
    else { const int seq = u; s.b = seq / 12; s.h = seq - s.b * 12; s.rb = 0; s.tok0 = NPT + s.b * 8; s.len = 8; s.first = true; s.last = true; s.prompt = false; }
    return s;
}
struct LReg { unsigned pr[8], pk[8], pv[8], qr[8], qk[8], qv[8], de[8], aa[8]; f32x4 st[4]; float mu_r, mu_k, mu_v, kkc, kac, rkc, w0c, a0c, f_r, f_k, f_v; };
__device__ __forceinline__ void scan_load(const KArgs& a, const SUnit& s, int lw, int lane, int ltid, LReg& R) {
    const unsigned char* ws = a.ws;
    const bf16_t* P = (const bf16_t*)(ws + WS_BIG); const bf16_t* LRO = (const bf16_t*)(ws + WS_LRO);
    const int ch = s.h * 64 + lane;
    R.mu_r = a.in[12][ch]; R.mu_k = a.in[12][768 + ch]; R.mu_v = a.in[12][1536 + ch]; R.kkc = a.in[18][ch]; R.kac = a.in[19][ch]; R.rkc = a.in[20][ch]; R.w0c = a.in[14][ch]; R.a0c = a.in[16][ch];
    R.f_r = 0.f; R.f_k = 0.f; R.f_v = 0.f;
    if (!s.prompt) { const float* sh = a.in[6] + (size_t)s.b * RWP + ch; R.f_r = sh[0]; R.f_k = sh[768]; R.f_v = sh[1536]; }
#pragma unroll
    for (int i = 0; i < 8; ++i) { const int tt = lw + 4 * i; const int ttc = tt < s.len ? tt : 0; const int tok = s.tok0 + ttc; const bool is0 = s.first && ttc == 0;
        if (i < 2 || s.prompt) {
            const bf16_t* row = P + (size_t)tok * PIN + ch; const bf16_t* rowm = P + (size_t)(is0 ? tok : tok - 1) * PIN + ch;
            R.pr[i] = row[0]; R.pk[i] = row[768]; R.pv[i] = row[1536];
            R.qr[i] = rowm[0]; R.qk[i] = rowm[768]; R.qv[i] = rowm[1536];
            R.de[i] = LRO[(size_t)tok * 2304 + ch]; R.aa[i] = LRO[(size_t)tok * 2304 + 768 + ch]; } }
    if (!s.prompt) { const f32x4* src = (const f32x4*)(a.in[7] + (size_t)(s.b * 12 + s.h) * 4096) + ltid;
#pragma unroll
        for (int q = 0; q < 4; ++q) R.st[q] = src[256 * q]; }
}
__device__ __forceinline__ void scan_store(const KArgs& a, const SUnit& s, float* buf, int lw, int lane, int ltid, const LReg& R) {
    float* BON = (float*)(a.ws + WS_BONUS);
    if (!s.prompt) { f32x4* dst = (f32x4*)(buf + 3072) + ltid;
#pragma unroll
        for (int q = 0; q < 4; ++q) dst[256 * q] = R.st[q]; }
#pragma unroll
    for (int i = 0; i < 8; ++i) { const int tt = lw + 4 * i;
        if (tt < s.len) { const int tok = s.tok0 + tt;
            const bool is0 = s.first && tt == 0;
            const float x = R.w0c + bflo(R.de[i]); const float sp = fmaxf(-x, 0.f) + 0.6931471806f * __builtin_amdgcn_logf(1.f + __expf(-fabsf(x))); const float dec = __expf(-__expf(-sp - 0.5f)); const float av = sigmoidf_(R.a0c + bflo(R.aa[i]));
            const float pr = bflo(R.pr[i]), pk = bflo(R.pk[i]), pv = bflo(R.pv[i]);
            const float qr = is0 ? R.f_r : bflo(R.qr[i]), qk = is0 ? R.f_k : bflo(R.qk[i]), qv = is0 ? R.f_v : bflo(R.qv[i]);
            const float sr = pr + R.mu_r * (qr - pr), sk = pk + R.mu_k * (qk - pk), sv = pv + R.mu_v * (qv - pv);
            const float kk = sk * R.kkc; const float n2 = wave_sum(kk * kk); const float kkn = kk * __builtin_amdgcn_rsqf(fmaxf(n2, 1e-24f));
            const float kq = sk * (1.f + (av - 1.f) * R.kac);
            float* vb = buf + tt * 320;
            vb[lane] = dec; vb[64 + lane] = -kkn; vb[128 + lane] = kkn * av; vb[192 + lane] = kq; vb[256 + lane] = sr;
            if (s.prompt) { if ((lane >> 4) == s.rb) buf[TC * 320 + tt * 16 + (lane & 15)] = sv; } else buf[2560 + tt * 64 + lane] = sv;
            if (s.rb == 0) { const float bs = wave_sum(sr * kq * R.rkc); if (lane == 0) BON[(size_t)tok * 12 + s.h] = bs; } } }
}
__device__ __forceinline__ void scan_flush(const KArgs& a, const SUnit& s, const float* outb, int ltid) {
    float* ORAW = (float*)(a.ws + WS_ORAW);
#pragma unroll
    for (int r = 0; r < 2; ++r) { const int e = ltid + 256 * r; const f32x4 qd = *(const f32x4*)(outb + e * 4); const float v = (qd[0] + qd[1]) + (qd[2] + qd[3]);
        if (s.prompt) { const int t = e >> 4, i = e & 15; ORAW[(size_t)(s.tok0 + t) * 768 + s.h * 64 + s.rb * 16 + i] = v; }
        else { const int t = e >> 6, i = e & 63; ORAW[(size_t)(s.tok0 + t) * 768 + s.h * 64 + i] = v; } }
}
typedef float f32x2 __attribute__((ext_vector_type(2)));
struct SV { f32x4 W, NK, B, KQ, R; float vv; };
__device__ __forceinline__ void sv_load(SV& x, const float* VB, const float* VV, int vstr, int t, int kg) {
    const float* vn = VB + t * 320 + kg * 4;
    x.W = *(const f32x4*)(vn); x.NK = *(const f32x4*)(vn + 64); x.B = *(const f32x4*)(vn + 128); x.KQ = *(const f32x4*)(vn + 192); x.R = *(const f32x4*)(vn + 256); x.vv = VV[t * vstr];
}
__device__ __forceinline__ void sv_step(f32x4& S, const SV& x, float* optr) {
    f32x2 p = S.lo * x.NK.lo; p = S.hi * x.NK.hi + p;
    float sa = p.x + p.y;
    f32x2 u0 = S.lo * x.W.lo; DPP_ADD(sa, 0xB1);
    f32x2 u1 = S.hi * x.W.hi; DPP_ADD(sa, 0x4E);
    u0 = x.KQ.lo * x.vv + u0; DPP_ADD(sa, 0x141);
    u1 = x.KQ.hi * x.vv + u1; DPP_ADD(sa, 0x140);
    S.lo = x.B.lo * sa + u0; S.hi = x.B.hi * sa + u1;
    f32x2 q = S.lo * x.R.lo; q = S.hi * x.R.hi + q;
    float o = q.x + q.y; DPP_ADD(o, 0xB1); DPP_ADD(o, 0x4E);
    *optr = o;
}
__device__ __forceinline__ void scan_steps(f32x4& S, const float* VB, const float* VV, int vstr, float* OB, int ostr, int len, int kg) {
    const int last = len - 1;
    SV A, B;
    sv_load(A, VB, VV, vstr, 0, kg);
#pragma unroll 1
    for (int t = 0; t < len; t += 2) {
        sv_load(B, VB, VV, vstr, t + 1, kg); sv_step(S, A, OB + t * ostr);
        sv_load(A, VB, VV, vstr, (t + 2 < last) ? t + 2 : last, kg); sv_step(S, B, OB + (t + 1) * ostr);
    }
}
__device__ __forceinline__ void phase3b(const KArgs& a, int wave, int lane) {
    unsigned char* ws = a.ws;
    const bf16_t* P = (const bf16_t*)(ws + WS_BIG); const bf16_t* LRO = (const bf16_t*)(ws + WS_LRO); float* BON = (float*)(ws + WS_BONUS);
    float* PW = (float*)(ws + WS_PW); float* PNK = (float*)(ws + WS_PNK); bf16_t* PB = (bf16_t*)(ws + WS_PB); bf16_t* PKQ = (bf16_t*)(ws + WS_PKQ); bf16_t* PR = (bf16_t*)(ws + WS_PR); bf16_t* PV = (bf16_t*)(ws + WS_PV);
    const int gw = blockIdx.x * 8 + wave, NGW = gridDim.x * 8;
    for (int task0 = gw * 8; task0 < NPT * 12; task0 += NGW * 8) { const int h = task0 / NPT, tok0 = task0 - h * NPT, ch = h * 64 + lane;
        unsigned upr[8], upk[8], upv[8], ude[8], uaa[8]; unsigned uqr, uqk, uqv;
        const int t0 = tok0 & (SEQ - 1), b = tok0 >> 11;
        { const bf16_t* rowm = P + (size_t)(t0 ? tok0 - 1 : tok0) * PIN + ch; uqr = rowm[0]; uqk = rowm[768]; uqv = rowm[1536]; }
#pragma unroll
        for (int q = 0; q < 8; ++q) { const bf16_t* row = P + (size_t)(tok0 + q) * PIN + ch; upr[q] = row[0]; upk[q] = row[768]; upv[q] = row[1536];
            ude[q] = LRO[(size_t)(tok0 + q) * 2304 + ch]; uaa[q] = LRO[(size_t)(tok0 + q) * 2304 + 768 + ch]; }
        const float w0c = a.in[14][ch], a0c = a.in[16][ch], mu_r = a.in[12][ch], mu_k = a.in[12][768 + ch], mu_v = a.in[12][1536 + ch], kkc = a.in[18][ch], kac = a.in[19][ch], rkc = a.in[20][ch];
        float qr = t0 ? bflo(uqr) : 0.f, qk = t0 ? bflo(uqk) : 0.f, qv = t0 ? bflo(uqv) : 0.f;
#pragma unroll
        for (int q = 0; q < 8; ++q) { const int tok = tok0 + q;
            const float pr = bflo(upr[q]), pk = bflo(upk[q]), pv = bflo(upv[q]);
            const float x = w0c + bflo(ude[q]); const float sp = fmaxf(-x, 0.f) + 0.6931471806f * __builtin_amdgcn_logf(1.f + __expf(-fabsf(x))); const float dec = __expf(-__expf(-sp - 0.5f)); const float av = sigmoidf_(a0c + bflo(uaa[q]));
            const float sr = pr + mu_r * (qr - pr), sk = pk + mu_k * (qk - pk), sv = pv + mu_v * (qv - pv);
            qr = pr; qk = pk; qv = pv;
            const float kk = sk * kkc; const float n2 = wave_sum(kk * kk); const float kkn = kk * __builtin_amdgcn_rsqf(fmaxf(n2, 1e-24f));
            const float kq = sk * (1.f + (av - 1.f) * kac);
            const size_t idx = ((size_t)(b * 12 + h) * SEQ + (t0 + q)) * 64 + lane;
            PW[idx] = dec; PNK[idx] = -kkn; PB[idx] = f2bf(kkn * av); PKQ[idx] = f2bf(kq); PR[idx] = f2bf(sr); PV[idx] = f2bf(sv);
            const float bs = wave_sum(sr * kq * rkc); if (lane == 0) BON[(size_t)tok * 12 + h] = bs; } }
}
struct CReg { f32x4 w0, w1, n0, n1; u32x4 b, kq, r; unsigned v; };
__device__ __forceinline__ void copy_load(const unsigned char* ws, int bh, int rb, int u, int ltid, CReg& C) {
    const size_t base = ((size_t)bh * SEQ + (size_t)u * TC) * 64;
    const f32x4* Wg = (const f32x4*)(ws + WS_PW) + base / 4; const f32x4* Ng = (const f32x4*)(ws + WS_PNK) + base / 4;
    C.w0 = Wg[ltid]; C.w1 = Wg[ltid + 256]; C.n0 = Ng[ltid]; C.n1 = Ng[ltid + 256];
    C.b = ((const u32x4*)(ws + WS_PB) + base / 8)[ltid]; C.kq = ((const u32x4*)(ws + WS_PKQ) + base / 8)[ltid]; C.r = ((const u32x4*)(ws + WS_PR) + base / 8)[ltid];
    C.v = ((const unsigned*)(ws + WS_PV) + base / 2)[(ltid >> 3) * 32 + rb * 8 + (ltid & 7)];
}
__device__ __forceinline__ void store8(float* d, const u32x4 w) { *(f32x4*)d = (f32x4){bflo(w.x), bfhi(w.x), bflo(w.y), bfhi(w.y)}; *(f32x4*)(d + 4) = (f32x4){bflo(w.z), bfhi(w.z), bflo(w.w), bfhi(w.w)}; }
__device__ __forceinline__ void copy_store(float* buf, int ltid, const CReg& C) {
    { const int e = ltid * 4, t = e >> 6, k = e & 63; *(f32x4*)(buf + t * 320 + k) = C.w0; *(f32x4*)(buf + t * 320 + 64 + k) = C.n0; }
    { const int e = (ltid + 256) * 4, t = e >> 6, k = e & 63; *(f32x4*)(buf + t * 320 + k) = C.w1; *(f32x4*)(buf + t * 320 + 64 + k) = C.n1; }
    { const int t = ltid >> 3, k = (ltid & 7) * 8; float* d = buf + t * 320 + k; store8(d + 128, C.b); store8(d + 192, C.kq); store8(d + 256, C.r);
      float* vd = buf + TC * 320 + t * 16 + (ltid & 7) * 2; vd[0] = bflo(C.v); vd[1] = bfhi(C.v); }
}
constexpr int LT_UP = 64 * 176, LT_DN = 176 * 32, LT_O = 64 * 32, LT_B01 = 24 * 32, LT_B2 = 16 * 32, LT_TOTAL = LT_UP + LT_DN + LT_O + 2 * LT_B01 + LT_B2;
struct LtItem { const float* W; bf16_t* WT; int K, N, kb, nb; };
__device__ __forceinline__ LtItem lt_decode(const KArgs& a, int it) {
    LtItem d; unsigned char* ws = a.ws; int nblk;
    if (it < LT_UP) { d.W = a.in[32]; d.WT = (bf16_t*)(ws + WS_WT_UP); d.K = DM; d.N = 2 * DFF; nblk = 176; }
    else if ((it -= LT_UP) < LT_DN) { d.W = a.in[35]; d.WT = (bf16_t*)(ws + WS_WT_DN); d.K = DFF; d.N = DM; nblk = 32; }
    else if ((it -= LT_DN) < LT_O) { d.W = a.in[29]; d.WT = (bf16_t*)(ws + WS_WT_O); d.K = DM; d.N = DM; nblk = 32; }
    else if ((it -= LT_O) < LT_B01) { d.W = a.in[26]; d.WT = (bf16_t*)(ws + WS_WT_BR0); d.K = 768; d.N = DM; nblk = 32; }
    else if ((it -= LT_B01) < LT_B01) { d.W = a.in[27]; d.WT = (bf16_t*)(ws + WS_WT_BR1); d.K = 768; d.N = DM; nblk = 32; }
    else { it -= LT_B01; d.W = a.in[28]; d.WT = (bf16_t*)(ws + WS_WT_BR2); d.K = 512; d.N = DM; nblk = 32; }
    d.kb = it / nblk; d.nb = it - d.kb * nblk; return d;
}
__device__ __forceinline__ void lt_load(const KArgs& a, int it, int lane, f32x4 (&v)[8]) {
    if (it < LT_TOTAL) { const LtItem d = lt_decode(a, it); const float* src = d.W + (size_t)(32 * d.kb + (lane >> 4)) * d.N + 64 * d.nb + (lane & 15) * 4;
#pragma unroll
        for (int i = 0; i < 8; ++i) v[i] = __builtin_nontemporal_load((const f32x4*)(src + (size_t)(4 * i) * d.N)); }
}
__device__ __forceinline__ void lt_store(const KArgs& a, int it, float* scr, int lane, const f32x4 (&v)[8]) {
    if (it < LT_TOTAL) { const LtItem d = lt_decode(a, it);
#pragma unroll
        for (int i = 0; i < 8; ++i) { float* p = scr + (4 * i + (lane >> 4)) * 65 + (lane & 15) * 4; p[0] = v[i][0]; p[1] = v[i][1]; p[2] = v[i][2]; p[3] = v[i][3]; }
        lds_fence();
        const int c = lane & 3;
#pragma unroll
        for (int j = 0; j < 4; ++j) { const int n = (lane >> 2) + 16 * j; const float* s = scr + (8 * c) * 65 + n;
            u32x4 o; o.x = cvt_pk_bf16(s[0 * 65], s[1 * 65]); o.y = cvt_pk_bf16(s[2 * 65], s[3 * 65]); o.z = cvt_pk_bf16(s[4 * 65], s[5 * 65]); o.w = cvt_pk_bf16(s[6 * 65], s[7 * 65]);
            *(u32x4*)(d.WT + (size_t)(64 * d.nb + n) * d.K + 32 * d.kb + 8 * c) = o; }
        lds_fence(); }
}
constexpr int CP_A = 131072 / 256, CP_B = 4194304 / 256, CP_C = (4 * RWP + 255) / 256, CP_D = (128 * RWP + 255) / 256, CP_TOTAL = CP_A + CP_B + CP_C + CP_D;
__device__ __forceinline__ void copy_item(const KArgs& a, int it, int lane) {
    if (it >= CP_TOTAL) return;
    const bf16_t* P = (const bf16_t*)(a.ws + WS_BIG); float* out = a.out;
    if (it < CP_A) { const int e = (it * 64 + lane) * 4, b = e >> 15, r = (e >> 8) & 127, c = e & 255; const size_t src = (size_t)(b * SEQ + 1920 + r) * PIN + c;
        const u32x2 kw = *(const u32x2*)(P + src + C_KSW), vw = *(const u32x2*)(P + src + C_VSW);
        *(f32x4*)(out + O_SWAK_P + e) = (f32x4){bflo(kw.x), bfhi(kw.x), bflo(kw.y), bfhi(kw.y)}; *(f32x4*)(out + O_SWAV_P + e) = (f32x4){bflo(vw.x), bfhi(vw.x), bflo(vw.y), bfhi(vw.y)}; return; }
    it -= CP_A;
    if (it < CP_B) { const int e = (it * 64 + lane) * 4, b = e >> 15, r = (e >> 8) & 127, c = e & 255; f32x4 kv, vv;
        if (r < 120) { kv = *(const f32x4*)(a.in[2] + (size_t)(b * 128 + r + 8) * 256 + c); vv = *(const f32x4*)(a.in[3] + (size_t)(b * 128 + r + 8) * 256 + c); }
        else { const size_t src = (size_t)(NPT + b * 8 + (r - 120)) * PIN + c; const u32x2 kw = *(const u32x2*)(P + src + C_KSW), vw = *(const u32x2*)(P + src + C_VSW);
            kv = (f32x4){bflo(kw.x), bfhi(kw.x), bflo(kw.y), bfhi(kw.y)}; vv = (f32x4){bflo(vw.x), bfhi(vw.x), bflo(vw.y), bfhi(vw.y)}; }
        *(f32x4*)(out + O_SWAK_S + e) = kv; *(f32x4*)(out + O_SWAV_S + e) = vv; return; }
    it -= CP_B;
    if (it < CP_C) { for (int q = 0; q < 4; ++q) { const int i = (it * 64 + lane) * 4 + q; if (i < 4 * RWP) { const int b = i / RWP, c = i - b * RWP; out[O_SHIFT_P + i] = bf2f(P[(size_t)(b * SEQ + SEQ - 1) * PIN + c]); } } return; }
    it -= CP_C;
    for (int q = 0; q < 4; ++q) { const int i = (it * 64 + lane) * 4 + q; if (i < 128 * RWP) { const int b = i / RWP, c = i - b * RWP; out[O_SHIFT_S + i] = bf2f(P[(size_t)(NPT + b * 8 + 7) * PIN + c]); } }
}
__device__ __forceinline__ void phase4(const KArgs& a, unsigned char* lds, int tid, int wave, int lane) {
    const int blk = blockIdx.x;
    float* bufs = (float*)lds; float* outs = (float*)(lds + SCAN_OUT_OFF);
    const int rs = lane >> 4, kg = lane & 15, w4 = wave & 3, ltid = tid - 256;
    if (blk < 192) {
        const int bh = blk >> 2, rb = blk & 3; constexpr int NU = SEQ / TC;
        f32x4 S = (f32x4){0.f, 0.f, 0.f, 0.f};
        CReg C;
        f32x4 tv[8]; float* tscr = (float*)(lds + 110592 + w4 * 8320); const int lt0 = blk * 4 + w4;
        if (wave >= 4) { copy_load(a.ws, bh, rb, 0, ltid, C); copy_store(bufs, ltid, C); copy_load(a.ws, bh, rb, 1, ltid, C); lt_load(a, lt0, lane, tv); }
        SCAN_BAR();
#pragma unroll 1
        for (int u = 0; u < NU; ++u) {
            if (wave < 4) { const int rl = w4 * 4 + rs; const float* VB = bufs + (u & 1) * SCAN_BUF_FLOATS; float* OB = outs + (u & 1) * 2048;
                scan_steps(S, VB, VB + TC * 320 + rl, 16, OB + rl * 4 + (kg >> 2), 64, TC, kg);
                if (u == NU - 1) *(f32x4*)(a.out + O_WKV_P + ((size_t)bh * 64 + rb * 16 + rl) * 64 + kg * 4) = S;
            } else {
                copy_store(bufs + ((u + 1) & 1) * SCAN_BUF_FLOATS, ltid, C);
                copy_load(a.ws, bh, rb, (u + 2 < NU) ? u + 2 : NU - 1, ltid, C);
                if (u > 0) { const SUnit sp = scan_unit(blk, u - 1); scan_flush(a, sp, outs + ((u - 1) & 1) * 2048, ltid); }
                lt_store(a, lt0 + 768 * u, tscr, lane, tv);
                lt_load(a, lt0 + 768 * (u + 1), lane, tv);
                if (u >= 28) copy_item(a, lt0 + 768 * (u - 28), lane);
            }
            SCAN_BAR();
        }
        if (wave >= 4) { const SUnit sp = scan_unit(blk, NU - 1); scan_flush(a, sp, outs + ((NU - 1) & 1) * 2048, ltid); }
        SCAN_BAR();
    }
    {
        const int NU = blk < 192 ? 0 : 24, q0 = blk < 192 ? 0 : (blk - 192) * 24;
        LReg R;
        if (wave >= 4 && NU > 0) { const SUnit s0 = scan_unit(999, q0); scan_load(a, s0, w4, lane, ltid, R); scan_store(a, s0, bufs, w4, lane, ltid, R);
            const SUnit s1 = scan_unit(999, q0 + 1); scan_load(a, s1, w4, lane, ltid, R); }
        SCAN_BAR();
#pragma unroll 1
        for (int u = 0; u < NU; ++u) {
            if (wave < 4) { const SUnit s = scan_unit(999, q0 + u); const float* VB = bufs + (u & 1) * SCAN_BUF_FLOATS; float* OB = outs + (u & 1) * 2048;
#pragma unroll 1
                for (int p = 0; p < 4; ++p) { const int row = w4 * 16 + p * 4 + rs;
                    f32x4 T = *(const f32x4*)(VB + 3072 + row * 64 + kg * 4);
                    scan_steps(T, VB, VB + 2560 + row, 64, OB + row * 4 + (kg >> 2), 256, 8, kg);
                    *(f32x4*)(a.out + O_WKV_S + ((size_t)(s.b * 12 + s.h) * 64 + row) * 64 + kg * 4) = T; }
            } else {
                if (u + 1 < NU) { const SUnit sn = scan_unit(999, q0 + u + 1); scan_store(a, sn, bufs + ((u + 1) & 1) * SCAN_BUF_FLOATS, w4, lane, ltid, R); }
                if (u + 2 < NU) { const SUnit sn2 = scan_unit(999, q0 + u + 2); scan_load(a, sn2, w4, lane, ltid, R); }
                if (u > 0) { const SUnit sp = scan_unit(999, q0 + u - 1); scan_flush(a, sp, outs + ((u - 1) & 1) * 2048, ltid); }
            }
            SCAN_BAR();
        }
        if (wave >= 4 && NU > 0) { const SUnit sp = scan_unit(999, q0 + NU - 1); scan_flush(a, sp, outs + ((NU - 1) & 1) * 2048, ltid); }
    }
    __syncthreads();
    if (blk >= 192) { for (int u = blk - 192; u < 512; u += 64) attn_mem_sample(a, lds, u, tid, wave, lane); }
    __syncthreads();
}
__device__ __forceinline__ void phase5(const KArgs& a, int wave, int lane) {
    const unsigned char* ws = a.ws;
    const bf16_t* P = (const bf16_t*)(ws + WS_BIG); const float* ORAW = (const float*)(ws + WS_ORAW); const bf16_t* LRO = (const bf16_t*)(ws + WS_LRO); const float* BON = (const float*)(ws + WS_BONUS);
    bf16_t* ORW = (bf16_t*)(a.ws + WS_ORW);
    const int gw = blockIdx.x * 8 + wave, NGW = gridDim.x * 8;
    for (int task0 = gw * 8; task0 < NTOK * 12; task0 += NGW * 8) { const int h = task0 / NTOK, tok0 = task0 - h * NTOK, ch = h * 64 + lane;
        float o[8], bon[8], shf[8]; unsigned upv[8], uqv[8], ug[8];
#pragma unroll
        for (int q = 0; q < 8; ++q) { const int tok = tok0 + q; bool is0; int bb = 0;
            if (tok < NPT) is0 = (tok & (SEQ - 1)) == 0; else { const int st = tok - NPT; is0 = (st & 7) == 0; bb = st >> 3; }
            o[q] = ORAW[(size_t)tok * 768 + ch]; upv[q] = P[(size_t)tok * PIN + 1536 + ch]; uqv[q] = P[(size_t)(is0 ? tok : tok - 1) * PIN + 1536 + ch];
            ug[q] = LRO[(size_t)tok * 2304 + 1536 + ch]; bon[q] = BON[(size_t)tok * 12 + h];
            shf[q] = (is0 && tok >= NPT) ? a.in[6][(size_t)bb * RWP + 1536 + ch] : 0.f; }
        const float lw = a.in[21][ch], lb = a.in[22][ch], muv = a.in[12][1536 + ch];
#pragma unroll
        for (int q = 0; q < 8; ++q) { const int tok = tok0 + q; const bool is0 = (tok < NPT) ? ((tok & (SEQ - 1)) == 0) : (((tok - NPT) & 7) == 0);
            const float mean = wave_sum(o[q]) * (1.f / 64.f); const float d = o[q] - mean; const float var = wave_sum(d * d) * (1.f / 64.f);
            const float on = d * __builtin_amdgcn_rsqf(var + 6.4e-4f) * lw + lb;
            const float pv = bflo(upv[q]); const float qv = is0 ? shf[q] : bflo(uqv[q]);
            const float sv = pv + muv * (qv - pv);
            ORW[(size_t)tok * 768 + ch] = f2bf((on + bon[q] * sv) * bflo(ug[q])); } }
}
__device__ __forceinline__ void row_vals8(const bf16_t* T, const float* SLAB, int m, int col, float (&v)[8]) {
    if (m < NPT) { const u32x4 w = *(const u32x4*)(T + (size_t)m * DM + col); v[0] = bflo(w.x); v[1] = bfhi(w.x); v[2] = bflo(w.y); v[3] = bfhi(w.y); v[4] = bflo(w.z); v[5] = bfhi(w.z); v[6] = bflo(w.w); v[7] = bfhi(w.w); }
    else { const float* sl = SLAB + (size_t)(m - NPT) * DM + col; f32x4 t0 = *(const f32x4*)sl, t1 = *(const f32x4*)(sl + 4);
#pragma unroll
        for (int ks = 1; ks < 8; ++ks) { t0 += *(const f32x4*)(sl + (size_t)ks * 1024 * DM); t1 += *(const f32x4*)(sl + (size_t)ks * 1024 * DM + 4); }
#pragma unroll
        for (int e = 0; e < 4; ++e) { v[e] = t0[e]; v[4 + e] = t1[e]; } }
}
__device__ __forceinline__ void phase8(const KArgs& a, int wave, int lane) {
    unsigned char* ws = a.ws; const bf16_t* T1 = (const bf16_t*)(ws + WS_MRG); const float* SLAB = (const float*)(ws + WS_SLAB); bf16_t* H = (bf16_t*)(ws + WS_H); bf16_t* HN = (bf16_t*)(ws + WS_XN);
    const int gw = blockIdx.x * 8 + wave, NGW = gridDim.x * 8;
    for (int m = gw; m < NTOK; m += NGW) {
        const float* xr = xrow_ptr(a, m);
        float v[4][8]; float s = 0.f;
#pragma unroll
        for (int j = 0; j < 4; ++j) { row_vals8(T1, SLAB, m, j * 512 + lane * 8, v[j]);
#pragma unroll
            for (int e = 0; e < 8; ++e) s += v[j][e] * v[j][e]; }
        const float rs = rsqrtf(wave_sum(s) * (1.f / DM) + NEPS); float s2 = 0.f;
#pragma unroll
        for (int j = 0; j < 4; ++j) { const int col = j * 512 + lane * 8;
            const f32x4 x0 = __builtin_nontemporal_load((const f32x4*)(xr + col)), x1 = __builtin_nontemporal_load((const f32x4*)(xr + col + 4)), g0 = *(const f32x4*)(a.in[30] + col), g1 = *(const f32x4*)(a.in[30] + col + 4);
#pragma unroll
            for (int e = 0; e < 4; ++e) { v[j][e] = x0[e] + v[j][e] * rs * g0[e]; v[j][4 + e] = x1[e] + v[j][4 + e] * rs * g1[e]; }
#pragma unroll
            for (int e = 0; e < 8; ++e) s2 += v[j][e] * v[j][e];
            u32x4 w; w.x = cvt_pk_bf16(v[j][0], v[j][1]); w.y = cvt_pk_bf16(v[j][2], v[j][3]); w.z = cvt_pk_bf16(v[j][4], v[j][5]); w.w = cvt_pk_bf16(v[j][6], v[j][7]);
            *(u32x4*)(H + (size_t)m * DM + col) = w; }
        const float rs2 = rsqrtf(wave_sum(s2) * (1.f / DM) + NEPS);
#pragma unroll
        for (int j = 0; j < 4; ++j) { const int col = j * 512 + lane * 8; const f32x4 g0 = *(const f32x4*)(a.in[31] + col), g1 = *(const f32x4*)(a.in[31] + col + 4);
            u32x4 w; w.x = cvt_pk_bf16(v[j][0] * rs2 * g0[0], v[j][1] * rs2 * g0[1]); w.y = cvt_pk_bf16(v[j][2] * rs2 * g0[2], v[j][3] * rs2 * g0[3]);
            w.z = cvt_pk_bf16(v[j][4] * rs2 * g1[0], v[j][5] * rs2 * g1[1]); w.w = cvt_pk_bf16(v[j][6] * rs2 * g1[2], v[j][7] * rs2 * g1[3]);
            *(u32x4*)(HN + (size_t)m * DM + col) = w; }
    }
}
__device__ __forceinline__ float gelu_tanh(float x) { const float u = 0.7978845608028654f * (x + 0.044715f * x * x * x); const float e = __expf(2.f * u); const float th = 1.f - 2.f * __builtin_amdgcn_rcpf(e + 1.f); return 0.5f * x * (1.f + th); }
__device__ __forceinline__ void unpack8(const u32x4 w, float (&f)[8]) { f[0] = bflo(w.x); f[1] = bfhi(w.x); f[2] = bflo(w.y); f[3] = bfhi(w.y); f[4] = bflo(w.z); f[5] = bfhi(w.z); f[6] = bflo(w.w); f[7] = bfhi(w.w); }
template <bool SL> __device__ __forceinline__ void z_ld(const bf16_t* Z, const float* SLU, int tok, int col, float (&v)[8]) {
    if (!SL) { unpack8(__builtin_nontemporal_load((const u32x4*)(Z + (size_t)tok * (2 * DFF) + col)), v); }
    else { const int pm = tok >> 8, pn = col >> 8; const int ti = (pm == 35) ? pn : pn + 4; const float* p = SLU + ((size_t)ti * 256 + (tok & 255)) * 256 + (col & 255);
        f32x4 t0 = *(const f32x4*)p, t1 = *(const f32x4*)(p + 4);
#pragma unroll
        for (int ks = 1; ks < 4; ++ks) { t0 += *(const f32x4*)(p + (size_t)ks * 48 * 65536); t1 += *(const f32x4*)(p + (size_t)ks * 48 * 65536 + 4); }
#pragma unroll
        for (int e = 0; e < 4; ++e) { v[e] = t0[e]; v[4 + e] = t1[e]; } }
}
__device__ __forceinline__ bool z_is_slab(int tok, int col) { const int pm = tok >> 8; return pm == 35 || (pm == 34 && (col >> 8) >= 40); }
template <bool SG, bool SV> __device__ __forceinline__ void conv_item(const KArgs& a, const bf16_t* Z, const float* SLU, bf16_t* ACT, float* out, const float* st8, int tokb, int c,
                                                                      const float (&w0)[8], const float (&w1)[8], const float (&w2)[8], const float (&bb)[8], float (&z1)[8], float (&z2)[8], int ntrips) {
    const bool smp = tokb >= NPT;
#pragma unroll 1
    for (int k4 = 0; k4 < ntrips; ++k4) { const int tok0 = tokb + k4 * 4;
        float zg[4][8], zw[4][8];
#pragma unroll
        for (int q = 0; q < 4; ++q) { if (!SG) z_ld<false>(Z, SLU, tok0 + q, c, zg[q]); if (!SV) z_ld<false>(Z, SLU, tok0 + q, DFF + c, zw[q]); }
        f32x4 s0a, s0b, s1a, s1b;
        const bool sstart = smp && ((tok0 & 7) == 0);
        if (sstart) { const float* p = st8 + (size_t)((tok0 - NPT) >> 3) * 2 * DFF + c; s0a = *(const f32x4*)p; s0b = *(const f32x4*)(p + 4); s1a = *(const f32x4*)(p + DFF); s1b = *(const f32x4*)(p + DFF + 4); }
        else { s0a = (f32x4){0.f, 0.f, 0.f, 0.f}; s0b = s0a; s1a = s0a; s1b = s0a; }
#pragma unroll
        for (int q = 0; q < 4; ++q) { const int tok = tok0 + q; float (&z0)[8] = zg[q]; float (&zv)[8] = zw[q];
            if (SG) { z_ld<true>(Z, SLU, tok, c, z0); asm volatile("" ::: "memory"); } if (SV) { z_ld<true>(Z, SLU, tok, DFF + c, zv); asm volatile("" ::: "memory"); }
            if (q == 0 && sstart) {
#pragma unroll
                for (int j = 0; j < 4; ++j) { z2[j] = s0a[j]; z2[j + 4] = s0b[j]; z1[j] = s1a[j]; z1[j + 4] = s1b[j]; } }
            float r[8];
#pragma unroll
            for (int j = 0; j < 8; ++j) { const float cv = bb[j] + w0[j] * z2[j] + w1[j] * z1[j] + w2[j] * z0[j]; r[j] = gelu_tanh(cv) * zv[j]; }
            u32x4 w; w.x = cvt_pk_bf16(r[0], r[1]); w.y = cvt_pk_bf16(r[2], r[3]); w.z = cvt_pk_bf16(r[4], r[5]); w.w = cvt_pk_bf16(r[6], r[7]);
            *(u32x4*)(ACT + (size_t)tok * DFF + c) = w;
            int t, T, b; if (!smp) { t = tok & (SEQ - 1); T = SEQ; b = tok >> 11; } else { const int st = tok - NPT; t = st & 7; T = 8; b = st >> 3; }
            if (t >= T - 2) { float* dst = out + (smp ? O_CONV_S : O_CONV_P) + ((size_t)b * 2 + (t - (T - 2))) * DFF + c;
                *(f32x4*)dst = (f32x4){z0[0], z0[1], z0[2], z0[3]}; *(f32x4*)(dst + 4) = (f32x4){z0[4], z0[5], z0[6], z0[7]}; }
#pragma unroll
            for (int j = 0; j < 8; ++j) { z2[j] = z1[j]; z1[j] = z0[j]; } } }
}
__device__ __forceinline__ void phase10(const KArgs& a, int tid) {
    unsigned char* ws = a.ws; const bf16_t* Z = (const bf16_t*)(ws + WS_BIG); const float* SLU = (const float*)(ws + WS_SLU); bf16_t* ACT = (bf16_t*)(ws + WS_ACT); float* out = a.out;
    const float* cw = a.in[33]; const float* cb = a.in[34]; const float* st8 = a.in[8];
    constexpr int N_LONG = 136 * 704, N_ITEMS = N_LONG + 32 * 704;
    for (int it = blockIdx.x * 512 + tid; it < N_ITEMS; it += gridDim.x * 512) {
        int tokb, c, ntrips;
        if (it < N_LONG) { const int run = 135 - it / 704; c = (it % 704) * 8; tokb = run * 64; ntrips = 16; }
        else { const int i2 = it - N_LONG, run = i2 / 704; c = (i2 - run * 704) * 8; tokb = 8704 + run * 16; ntrips = 4; }
        float w0[8], w1[8], w2[8], bb[8];
#pragma unroll
        for (int j = 0; j < 8; ++j) { bb[j] = cb[c + j]; w0[j] = cw[c + j]; w1[j] = cw[DFF + c + j]; w2[j] = cw[2 * DFF + c + j]; }
        float z1[8], z2[8];
        { const int t = (tokb >= NPT) ? 0 : (tokb & (SEQ - 1));
          if (t >= 2) { z_ld<false>(Z, SLU, tokb - 1, c, z1); z_ld<false>(Z, SLU, tokb - 2, c, z2); }
          else {
#pragma unroll
              for (int j = 0; j < 8; ++j) { z1[j] = 0.f; z2[j] = 0.f; } } }
        const bool sg = z_is_slab(tokb, c), sv = z_is_slab(tokb, DFF + c);
        if (!sv) conv_item<false, false>(a, Z, SLU, ACT, out, st8, tokb, c, w0, w1, w2, bb, z1, z2, ntrips);
        else if (!sg) conv_item<false, true>(a, Z, SLU, ACT, out, st8, tokb, c, w0, w1, w2, bb, z1, z2, ntrips);
        else conv_item<true, true>(a, Z, SLU, ACT, out, st8, tokb, c, w0, w1, w2, bb, z1, z2, ntrips);
    }
}
__device__ __forceinline__ void phase12(const KArgs& a, int wave, int lane) {
    const unsigned char* ws = a.ws; const bf16_t* F = (const bf16_t*)(ws + WS_MRG); const float* SLAB = (const float*)(ws + WS_SLAB); const bf16_t* H = (const bf16_t*)(ws + WS_H);
    const int gw = blockIdx.x * 8 + wave, NGW = gridDim.x * 8;
    for (int m = gw; m < NTOK; m += NGW) {
        float v[4][8]; float s = 0.f; u32x4 hw[4];
#pragma unroll
        for (int j = 0; j < 4; ++j) { row_vals8(F, SLAB, m, j * 512 + lane * 8, v[j]); hw[j] = *(const u32x4*)(H + (size_t)m * DM + j * 512 + lane * 8);
#pragma unroll
            for (int e = 0; e < 8; ++e) s += v[j][e] * v[j][e]; }
        const float rs = rsqrtf(wave_sum(s) * (1.f / DM) + NEPS);
#pragma unroll
        for (int j = 0; j < 4; ++j) { const int col = j * 512 + lane * 8; const f32x4 g0 = *(const f32x4*)(a.in[36] + col), g1 = *(const f32x4*)(a.in[36] + col + 4);
            float h[8]; unpack8(hw[j], h);
            f32x4 y0, y1;
#pragma unroll
            for (int e = 0; e < 4; ++e) { y0[e] = h[e] + v[j][e] * rs * g0[e]; y1[e] = h[4 + e] + v[j][4 + e] * rs * g1[e]; }
            __builtin_nontemporal_store(y0, (f32x4*)(a.out + (size_t)m * DM + col)); __builtin_nontemporal_store(y1, (f32x4*)(a.out + (size_t)m * DM + col + 4)); }
    }
}

#define PH_IDS() const int tid = opaque_tid(), lane = tid & 63, wave = __builtin_amdgcn_readfirstlane(tid >> 6); (void)lane; (void)wave
__global__ void __launch_bounds__(512) fwd_megakernel(KArgs a) {
    unsigned char* lds = g_lds;
    cg::grid_group grid = cg::this_grid();
    unsigned char* ws = a.ws;
    PG8_LAS unsigned char* ldsa = (PG8_LAS unsigned char*)lds;
    const int G = gridDim.x, c = blockIdx.x;
    bf16_t* P = (bf16_t*)(ws + WS_BIG);
    volatile PG8_LAS unsigned* bst = (volatile PG8_LAS unsigned*)(ldsa + (LDS_BYTES - 16));
    if (threadIdx.x < 4) bst[threadIdx.x] = 0u;
    if (threadIdx.x == 0) {
#pragma unroll
        for (int k = 0; k < 37; ++k) *(unsigned long long*)(g_lds + PTAB_OFF + 8 * k) = (unsigned long long)a.in[k]; }
    __syncthreads();
    const XcdBarrier xbar = xcd_barrier_post((unsigned*)(ws + WS_BAR), bst);
    if (a.ws == nullptr) grid.sync();

#if !defined(ONLY) || ONLY == 0
    { PH_IDS(); phase0(a, lds, tid, wave, lane); }
#endif
    xcd_barrier(xbar);
#if !defined(ONLY) || ONLY == 1
    { pg8::Gemm g{(const bf16_t*)(ws + WS_XN), (const bf16_t*)(ws + WS_WT_IN), NTOK, PIN, DM}; pg8::StaticOrder S; S.init(NTOK, PIN, G, c);
      EpiB16 E{P, PIN, C_GATE / 256}; pg8::gemm_phase<EpiB16, pg8::StaticOrder>(ldsa, g, S, E, nullptr); }
    { pg8::Gemm g{(const bf16_t*)(ws + WS_MEMN), (const bf16_t*)(ws + WS_WT_MEMKV), 1024, 1024, DM}; pg8::StaticOrder S; S.init(1024, 1024, G, (c + G - 196) % G);
      EpiMemKV E{a.out + O_MEMK_P, a.out + O_MEMV_P, (bf16_t*)(ws + WS_MEMKV)}; pg8::gemm_phase<EpiMemKV, pg8::StaticOrder>(ldsa, g, S, E, nullptr); }
#endif
    xcd_barrier(xbar);
#if !defined(ONLY) || ONLY == 2
    { PH_IDS(); phase2(a, lds, tid, wave, lane); }
#endif
    xcd_barrier(xbar);
#if !defined(ONLY) || ONLY == 3
    { pg8::Gemm g{(const bf16_t*)(ws + WS_ALR), (const bf16_t*)(ws + WS_WT_LR), NTOK, 2304, 256}; pg8::StaticOrder S; S.init(NTOK, 2304, G, c);
      EpiB16 E{(bf16_t*)(ws + WS_LRO), 2304, 1 << 30}; pg8::gemm_phase<EpiB16, pg8::StaticOrder>(ldsa, g, S, E, nullptr); }
#endif
    xcd_barrier(xbar);
#if !defined(ONLY) || ONLY == 4
    { PH_IDS(); phase3b(a, wave, lane); }
    xcd_barrier(xbar);
    { PH_IDS(); phase4(a, lds, tid, wave, lane); }
#endif
    xcd_barrier(xbar);
#if !defined(ONLY) || ONLY == 5
    { PH_IDS(); phase5(a, wave, lane); }
#endif
    xcd_barrier(xbar);
#if !defined(ONLY) || ONLY == 6
    { pg8::StaticOrder S; S.init(8192, DM, G, c);
      { pg8::Gemm g{(const bf16_t*)(ws + WS_ORW), (const bf16_t*)(ws + WS_WT_BR0), NTOK, DM, 768}; EpiBr<0> E{(float*)(ws + WS_MRG), nullptr, P + C_GATE}; pg8::gemm_phase<EpiBr<0>, pg8::StaticOrder>(ldsa, g, S, E, nullptr); }
      { pg8::Gemm g{(const bf16_t*)(ws + WS_OSW), (const bf16_t*)(ws + WS_WT_BR1), NTOK, DM, 768}; EpiBr<1> E{(float*)(ws + WS_MRG), nullptr, P + C_GATE + DM}; pg8::gemm_phase<EpiBr<1>, pg8::StaticOrder>(ldsa, g, S, E, nullptr); }
      { pg8::Gemm g{(const bf16_t*)(ws + WS_OMEM), (const bf16_t*)(ws + WS_WT_BR2), NTOK, DM, 512}; EpiBr<2> E{(float*)(ws + WS_MRG), (bf16_t*)(ws + WS_MERGEDB), P + C_GATE + 2 * DM}; pg8::gemm_phase<EpiBr<2>, pg8::StaticOrder>(ldsa, g, S, E, nullptr); } }
    { const BrSplit S0{c, 0}, S1{c, 1}, S2{c, 2};
      { pg8::Gemm g{(const bf16_t*)(ws + WS_ORW), (const bf16_t*)(ws + WS_WT_BR0), NTOK, DM, 768}; EpiBrS E{(float*)(ws + WS_SLB), P + C_GATE}; pg8::gemm_phase<EpiBrS, BrSplit>(ldsa, g, S0, E, nullptr); }
      { pg8::Gemm g{(const bf16_t*)(ws + WS_OSW), (const bf16_t*)(ws + WS_WT_BR1), NTOK, DM, 768}; EpiBrS E{(float*)(ws + WS_SLB), P + C_GATE + DM}; pg8::gemm_phase<EpiBrS, BrSplit>(ldsa, g, S1, E, nullptr); }
      { pg8::Gemm g{(const bf16_t*)(ws + WS_OMEM), (const bf16_t*)(ws + WS_WT_BR2), NTOK, DM, 512}; EpiBrS E{(float*)(ws + WS_SLB), P + C_GATE + 2 * DM}; pg8::gemm_phase<EpiBrS, BrSplit>(ldsa, g, S2, E, nullptr); } }
    xcd_barrier(xbar);
    { PH_IDS(); const float* SLB = (const float*)(ws + WS_SLB); bf16_t* MB = (bf16_t*)(ws + WS_MERGEDB);
      for (int it = blockIdx.x * 512 + tid; it < 1024 * DM / 8; it += gridDim.x * 512) { const float* p = SLB + (size_t)it * 8; f32x4 t0 = *(const f32x4*)p, t1 = *(const f32x4*)(p + 4);
#pragma unroll
          for (int ks = 1; ks < 8; ++ks) { t0 += *(const f32x4*)(p + (size_t)ks * 1024 * DM); t1 += *(const f32x4*)(p + (size_t)ks * 1024 * DM + 4); }
          u32x4 w; w.x = cvt_pk_bf16(t0[0], t0[1]); w.y = cvt_pk_bf16(t0[2], t0[3]); w.z = cvt_pk_bf16(t1[0], t1[1]); w.w = cvt_pk_bf16(t1[2], t1[3]);
          *(u32x4*)(MB + (size_t)NPT * DM + (size_t)it * 8) = w; } }
    xcd_barrier(xbar);
    { pg8::Gemm g{(const bf16_t*)(ws + WS_MERGEDB), (const bf16_t*)(ws + WS_WT_O), NTOK, DM, DM}; RemOrder S; S.init(G, c, DM);
      EpiB16S E{(bf16_t*)(ws + WS_MRG), (float*)(ws + WS_SLAB)}; pg8::gemm_phase<EpiB16S, RemOrder>(ldsa, g, S, E, nullptr); }
#endif
    xcd_barrier(xbar);
#if !defined(ONLY) || ONLY == 8
    { PH_IDS(); phase8(a, wave, lane); }
#endif
    xcd_barrier(xbar);
#if !defined(ONLY) || ONLY == 9
    { pg8::Gemm g{(const bf16_t*)(ws + WS_XN), (const bf16_t*)(ws + WS_WT_UP), NTOK, 2 * DFF, DM}; UpOrder S; S.init(G, c);
      EpiZ E{P, (float*)(ws + WS_SLU)}; pg8::gemm_phase<EpiZ, UpOrder>(ldsa, g, S, E, nullptr); }
#endif
    xcd_barrier(xbar);
#if !defined(ONLY) || ONLY == 10
    { PH_IDS(); phase10(a, tid); }
#endif
    xcd_barrier(xbar);
#if !defined(ONLY) || ONLY == 11
    { pg8::Gemm g{(const bf16_t*)(ws + WS_ACT), (const bf16_t*)(ws + WS_WT_DN), NTOK, DM, DFF}; RemOrder S; S.init(G, c, DFF);
      EpiB16S E{(bf16_t*)(ws + WS_MRG), (float*)(ws + WS_SLAB)}; pg8::gemm_phase<EpiB16S, RemOrder>(ldsa, g, S, E, nullptr); }
#endif
    xcd_barrier(xbar);
#if !defined(ONLY) || ONLY == 12
    { PH_IDS(); phase12(a, wave, lane); }
#endif

}

extern "C" void kernel_launch(void* const* d_in, const int* in_sizes, int n_in, void* d_out, int out_size, void* d_ws, size_t ws_size, hipStream_t stream) {
    static int grid_blocks = 0;
    if (grid_blocks == 0) {
        if (n_in != 37 || (size_t)out_size != O_END || ws_size < WS_TOTAL) { fprintf(stderr, "kernel_launch: unexpected problem (n_in %d out %d ws %zu need %zu)\n", n_in, out_size, ws_size, (size_t)WS_TOTAL); grid_blocks = -1; return; }
        if (hipFuncSetAttribute((const void*)fwd_megakernel, hipFuncAttributeMaxDynamicSharedMemorySize, LDS_BYTES) != hipSuccess) { fprintf(stderr, "kernel_launch: hipFuncSetAttribute failed\n"); grid_blocks = -1; return; }
        int dev = 0, cus = 0, per_cu = 0;
        (void)hipGetDevice(&dev); (void)hipDeviceGetAttribute(&cus, hipDeviceAttributeMultiprocessorCount, dev);
        (void)hipOccupancyMaxActiveBlocksPerMultiprocessor(&per_cu, (const void*)fwd_megakernel, 512, LDS_BYTES);
        (void)hipGetLastError();
        if (cus < 256 || per_cu < 1) fprintf(stderr, "kernel_launch: note: cus %d per_cu %d\n", cus, per_cu);
        grid_blocks = 256;
    }
    if (grid_blocks < 0) return;
    if (hipMemsetAsync((char*)d_ws + WS_BAR, 0, XCD_BAR_WORDS * 4, stream) != hipSuccess) { fprintf(stderr, "kernel_launch: memset failed\n"); return; }
    KArgs a{};
    for (int i = 0; i < 37; ++i) a.in[i] = (const float*)d_in[i];
    a.out = (float*)d_out; a.ws = (unsigned char*)d_ws;
    void* args[] = {&a};
    hipError_t e = hipLaunchCooperativeKernel((const void*)fwd_megakernel, dim3(grid_blocks), dim3(512), args, LDS_BYTES, stream);
    if (e != hipSuccess) fprintf(stderr, "cooperative launch failed: %s (grid %d)\n", hipGetErrorString(e), grid_blocks);
}
```
